# Optimizing an MI355X kernel written in HIP

```python
import math
import jax, jax.numpy as jnp
from jax import lax
import numpy as np

D_MODEL = 2048
BATCH = 1
SEQ = 16384
DEPTH = 1

HEAD_DIM = 128
GRID_W = 64
Q_BLOCK = 128
A_Q_HEADS = 8
A_KV_HEADS = 2
A_GROUP = A_Q_HEADS // A_KV_HEADS
B_HEADS = 8
WIN_ROWS_MAX = 8
WIN_COLS = 16
A_WIDTH = A_Q_HEADS * HEAD_DIM
B_WIDTH = B_HEADS * HEAD_DIM
MIX_WIDTH = A_WIDTH + B_WIDTH
A_KV_WIDTH = A_KV_HEADS * HEAD_DIM
IN_WIDTH = A_WIDTH + 2 * A_KV_WIDTH + 3 * B_WIDTH
D_FF = 4 * D_MODEL
PLE_DIM = 256
ROPE_THETA = 10000.0
ROPE_AXIS_DIM = HEAD_DIM // 2
NORM_EPS = 1e-6

kernel_name = "hybrid_gqa_axialrope_neighbourhood_attn_layer"


def rms_norm(x, g):
    xf = x.astype(jnp.float32)
    y = xf * lax.rsqrt(jnp.mean(xf * xf, axis=-1, keepdims=True) + NORM_EPS)
    return (y * g.astype(jnp.float32)).astype(x.dtype)


def rope_half(x, ang):
    n = ang.shape[-1]
    shape = (1, ang.shape[0]) + (1,) * (x.ndim - 3) + (n,)
    cos = jnp.cos(ang).reshape(shape)
    sin = jnp.sin(ang).reshape(shape)
    xf = x.astype(jnp.float32)
    x1, x2 = xf[..., :n], xf[..., n:]
    return jnp.concatenate([x1 * cos - x2 * sin, x2 * cos + x1 * sin], axis=-1).astype(x.dtype)


def axial_rope(x, ang_row, ang_col):
    return jnp.concatenate([rope_half(x[..., :ROPE_AXIS_DIM], ang_row),
                            rope_half(x[..., ROPE_AXIS_DIM:], ang_col)], axis=-1)


def to_blocks(a):
    b, s = a.shape[0], a.shape[1]
    a = a.reshape((b, s // Q_BLOCK, Q_BLOCK) + a.shape[2:])
    return jnp.moveaxis(a, 1, 0)


def from_blocks(a):
    a = jnp.moveaxis(a, 0, 1)
    return a.reshape((a.shape[0], a.shape[1] * a.shape[2]) + a.shape[3:])


def global_gqa(q, k, v):
    scale = 1.0 / math.sqrt(HEAD_DIM)

    def block(qb):
        s = jnp.einsum('bqkgd,bskd->bkgqs', qb, k).astype(jnp.float32) * scale
        w = jax.nn.softmax(s, axis=-1).astype(v.dtype)
        return jnp.einsum('bkgqs,bskd->bqkgd', w, v)

    o = lax.map(block, to_blocks(q))
    return from_blocks(o)


def neighbourhood_attn(q, k, v, rpb, rows):
    s_len = q.shape[1]
    win_r = min(WIN_ROWS_MAX, rows)
    scale = 1.0 / math.sqrt(HEAD_DIM)
    t_blocks = jnp.arange(s_len, dtype=jnp.int32).reshape(s_len // Q_BLOCK, Q_BLOCK)
    ar_r = jnp.arange(win_r, dtype=jnp.int32)
    ar_c = jnp.arange(WIN_COLS, dtype=jnp.int32)

    def block(args):
        qb, t = args
        r = t // GRID_W
        c = t % GRID_W
        r0 = jnp.clip(r - win_r // 2, 0, rows - win_r)
        c0 = jnp.clip(c - WIN_COLS // 2, 0, GRID_W - WIN_COLS)
        kr = r0[:, None] + ar_r[None, :]
        kc = c0[:, None] + ar_c[None, :]
        idx = (kr[:, :, None] * GRID_W + kc[:, None, :]).reshape(Q_BLOCK, win_r * WIN_COLS)
        dr = kr - r[:, None] + (WIN_ROWS_MAX - 1)
        dc = kc - c[:, None] + (WIN_COLS - 1)
        bias = rpb[:, dr[:, :, None], dc[:, None, :]].reshape(B_HEADS, Q_BLOCK, win_r * WIN_COLS)
        kg = k[:, idx]
        vg = v[:, idx]
        s = jnp.einsum('bqhd,bqnhd->bhqn', qb, kg).astype(jnp.float32) * scale
        s = s + bias.astype(jnp.float32)[None]
        w = jax.nn.softmax(s, axis=-1).astype(vg.dtype)
        return jnp.einsum('bhqn,bqnhd->bqhd', w, vg)

    o = lax.map(block, (to_blocks(q), t_blocks))
    return from_blocks(o)


def setup_inputs(seed: int = 0) -> dict:
    key = jax.random.key(seed)
    ks = jax.random.split(key, 20)
    f32 = jnp.float32

    def w(k, shape, fan_in):
        return jax.random.normal(k, shape, f32) * (fan_in ** -0.5)

    def gain(k, shape):
        return 1.0 + 0.05 * jax.random.normal(k, shape, f32)

    return {
        "x": jax.random.normal(ks[0], (BATCH, SEQ, D_MODEL), f32),
        "p": jax.random.normal(ks[1], (DEPTH, BATCH, SEQ, PLE_DIM), f32),
        "pre_mix_norm": gain(ks[2], (DEPTH, D_MODEL)),
        "w_in": w(ks[3], (DEPTH, D_MODEL, IN_WIDTH), D_MODEL),
        "q_norm": gain(ks[4], (DEPTH, HEAD_DIM)),
        "k_norm": gain(ks[5], (DEPTH, HEAD_DIM)),
        "rel_pos_bias": 0.1 * jax.random.normal(ks[6], (DEPTH, B_HEADS, 2 * WIN_ROWS_MAX - 1, 2 * WIN_COLS - 1), f32),
        "w_o": w(ks[7], (DEPTH, MIX_WIDTH, D_MODEL), MIX_WIDTH),
        "post_mix_norm": gain(ks[8], (DEPTH, D_MODEL)),
        "pre_mlp_norm": gain(ks[9], (DEPTH, D_MODEL)),
        "w_up": w(ks[10], (DEPTH, D_MODEL, D_FF), D_MODEL),
        "w_down": w(ks[11], (DEPTH, D_FF, D_MODEL), D_FF),
        "post_mlp_norm": gain(ks[12], (DEPTH, D_MODEL)),
        "pre_ple_norm": gain(ks[13], (DEPTH, D_MODEL)),
        "w_ple_gate": w(ks[14], (DEPTH, D_MODEL, D_MODEL), D_MODEL),
        "w_ple_proj": w(ks[15], (DEPTH, PLE_DIM, D_MODEL), PLE_DIM),
        "post_ple_norm": gain(ks[16], (DEPTH, D_MODEL)),
    }


def reference(x, p, pre_mix_norm, w_in, q_norm, k_norm, rel_pos_bias, w_o, post_mix_norm,
              pre_mlp_norm, w_up, w_down, post_mlp_norm, pre_ple_norm, w_ple_gate, w_ple_proj,
              post_ple_norm):
    b, s_len, _ = x.shape
    rows = s_len // GRID_W
    t = jnp.arange(s_len, dtype=jnp.int32)
    row = (t // GRID_W).astype(jnp.float32)
    col = (t % GRID_W).astype(jnp.float32)
    n_freq = ROPE_AXIS_DIM // 2
    freqs = ROPE_THETA ** (-jnp.arange(n_freq, dtype=jnp.float32) / n_freq)
    ang_row = row[:, None] * freqs[None, :]
    ang_col = col[:, None] * freqs[None, :]

    h = x
    for i in range(DEPTH):
        xn = rms_norm(h, pre_mix_norm[i])
        proj = xn @ w_in[i]
        o0 = A_WIDTH
        o1 = o0 + A_KV_WIDTH
        o2 = o1 + A_KV_WIDTH
        o3 = o2 + B_WIDTH
        o4 = o3 + B_WIDTH
        qa = proj[..., :o0].reshape(b, s_len, A_KV_HEADS, A_GROUP, HEAD_DIM)
        ka = proj[..., o0:o1].reshape(b, s_len, A_KV_HEADS, HEAD_DIM)
        va = proj[..., o1:o2].reshape(b, s_len, A_KV_HEADS, HEAD_DIM)
        qb = proj[..., o2:o3].reshape(b, s_len, B_HEADS, HEAD_DIM)
        kb = proj[..., o3:o4].reshape(b, s_len, B_HEADS, HEAD_DIM)
        vb = proj[..., o4:].reshape(b, s_len, B_HEADS, HEAD_DIM)

        qa = axial_rope(rms_norm(qa, q_norm[i]), ang_row, ang_col)
        ka = axial_rope(rms_norm(ka, k_norm[i]), ang_row, ang_col)
        out_a = global_gqa(qa, ka, va).reshape(b, s_len, A_WIDTH)
        out_b = neighbourhood_attn(qb, kb, vb, rel_pos_bias[i], rows).reshape(b, s_len, B_WIDTH)

        mix = jnp.concatenate([out_a, out_b], axis=-1) @ w_o[i]
        h = h + rms_norm(mix, post_mix_norm[i])

        m = rms_norm(h, pre_mlp_norm[i]) @ w_up[i]
        m = jnp.square(jax.nn.relu(m)) @ w_down[i]
        h = h + rms_norm(m, post_mlp_norm[i])

        gate = jax.nn.sigmoid(rms_norm(h, pre_ple_norm[i]) @ w_ple_gate[i])
        e = (p[i] @ w_ple_proj[i]) * gate
        h = h + rms_norm(e, post_ple_norm[i])
    return h
```

```cpp
#include <hip/hip_runtime.h>
#include <hip/hip_bf16.h>
#include <hip/hip_cooperative_groups.h>
#include <cstdio>
#include <cstdint>
#include <cmath>
namespace cg = cooperative_groups;
namespace pg8 {
#define PG8_LAS __attribute__((address_space(3)))
typedef unsigned short bf16_t;
typedef short bf16x8 __attribute__((ext_vector_type(8)));
typedef float f32x4 __attribute__((ext_vector_type(4)));
typedef unsigned u32x4 __attribute__((ext_vector_type(4)));
constexpr int BM = 256, BK = 64, HALF = 128, HTB = HALF * BK * 2  , STAGE_BYTES = 8 * HTB, NXCD = 8, WGM = 8;

__host__ __device__ __forceinline__ int lds_byte(int r, int c) { const int st = (r >> 4) * 2 + (c >> 5), rr = r & 15, cc = c & 31, ob = rr * 64 + cc * 2; return st * 1024 + (ob ^ (((ob >> 9) & 1) << 5)); }
__host__ __device__ __forceinline__ void stage_rc(int b, int& R, int& C) { const int st = b / 1024, sb = b % 1024, swz = sb ^ (((sb >> 9) & 1) << 5); R = (st >> 1) * 16 + swz / 64; C = (st & 1) * 32 + (swz % 64) / 2; }
__host__ __device__ __forceinline__ int perm32(int rho) { const int n = rho >> 4, i = rho & 15; return 8 * (i >> 2) + 4 * n + (i & 3); }

struct Unit { int pm, pn; };
struct Gemm { const bf16_t* A; const bf16_t* Bt; int M, N, K; };

struct StaticOrder {
    int nM, nN, nwg, G, c;
    __host__ __device__ void init(int M, int N, int G_, int c_) { nM = M / BM; nN = N / BM; nwg = nM * nN; G = G_; c = c_; }
    __host__ __device__ bool next(int i, Unit& u) const {
        const long L = (long)i * G + c; if (L >= nwg) return false;
        int wgid = (int)L; { const int q = nwg / NXCD, r = nwg % NXCD, xcd = wgid % NXCD, off = wgid / NXCD; wgid = (xcd < r ? xcd * (q + 1) : r * (q + 1) + (xcd - r) * q) + off; }
        const int nig = WGM * nN, gid = wgid / nig, fm = gid * WGM, gsz = (nM - fm) < WGM ? (nM - fm) : WGM;
        u.pm = fm + ((wgid % nig) % gsz); u.pn = (wgid % nig) / gsz; return true;
    }
    __device__ __forceinline__ void a_ready(const Unit&) const {}
    __device__ __forceinline__ void done(const Unit&) const {}
};

__device__ __forceinline__ unsigned cvt_pk_bf16(float lo, float hi) { unsigned r; asm volatile("v_cvt_pk_bf16_f32 %0, %1, %2" : "=v"(r) : "v"(lo), "v"(hi)); return r; }
template <int ACT  > struct EpiBf16 {
    static constexpr bool PERM = true, AFTER_DRAIN = false;
    bf16_t* O; int ldc;
    __device__ __forceinline__ void operator()(const f32x4 (&acc)[2][2][4][2], const Unit& u, int wr, int wc, int fr, int fq) const {
        const int row0 = u.pm * BM + wr * 64 + fr; const int col0 = u.pn * BM + wc * 32 + 8 * fq;
#pragma unroll
        for (int ai = 0; ai < 2; ++ai)
#pragma unroll
            for (int m = 0; m < 4; ++m) { bf16_t* rowp = O + (size_t)(row0 + ai * HALF + m * 16) * ldc + col0;
#pragma unroll
                for (int bj = 0; bj < 2; ++bj) { f32x4 v0 = acc[ai][bj][m][0], v1 = acc[ai][bj][m][1];
                    if (ACT == 2) {
#pragma unroll
                        for (int e = 0; e < 4; ++e) { float a = fmaxf(v0[e], 0.f), b = fmaxf(v1[e], 0.f); v0[e] = a * a; v1[e] = b * b; } }
                    u32x4 w; w.x = cvt_pk_bf16(v0[0], v0[1]); w.y = cvt_pk_bf16(v0[2], v0[3]); w.z = cvt_pk_bf16(v1[0], v1[1]); w.w = cvt_pk_bf16(v1[2], v1[3]);
                    *(u32x4*)(rowp + bj * HALF) = w; } }
    }
};
template <int MODE  > struct EpiF32 {
    static constexpr bool PERM = false, AFTER_DRAIN = false;
    float* C; int ldc;
    __device__ __forceinline__ void operator()(const f32x4 (&acc)[2][2][4][2], const Unit& u, int wr, int wc, int fr, int fq) const {
        const int row0 = u.pm * BM + wr * 64 + fr, col0 = u.pn * BM + wc * 32 + 4 * fq;
#pragma unroll
        for (int ai = 0; ai < 2; ++ai)
#pragma unroll
            for (int m = 0; m < 4; ++m) { float* rowp = C + (size_t)(row0 + ai * HALF + m * 16) * ldc + col0;
#pragma unroll
                for (int bj = 0; bj < 2; ++bj)
#pragma unroll
                    for (int n = 0; n < 2; ++n) {
                        f32x4 v = acc[ai][bj][m][n];
                        if (MODE == 1) { const f32x4 e = *(const f32x4*)(rowp + bj * HALF + n * 16);
#pragma unroll
                            for (int k = 0; k < 4; ++k) v[k] = e[k] * __builtin_amdgcn_rcpf(1.f + __expf(-v[k])); }
                        *(f32x4*)(rowp + bj * HALF + n * 16) = v; } }
    }
};

template <class Epi, class Sched, bool ALIGN_EPI = false, bool SP2 = false>
__device__ __forceinline__ void gemm_phase(PG8_LAS unsigned char* lds, const Gemm g, const Sched& S, const Epi& E, int wave_s) {
    int lane_ = __builtin_amdgcn_mbcnt_hi(~0u, __builtin_amdgcn_mbcnt_lo(~0u, 0u)); asm volatile("" : "+v"(lane_));
    const int tid = wave_s * 64 + lane_, wid = __builtin_amdgcn_readfirstlane(tid >> 6), lane = tid & 63, wr = wid >> 2, wc = wid & 3, fr = lane & 15, fq = lane >> 4;
    const int K = g.K, nt = K / BK;
    unsigned voffA[2], voffB[2];
#pragma unroll
    for (int i = 0; i < 2; ++i) { int R, C; stage_rc(tid * 16 + i * 8192, R, C); const int Rb = Epi::PERM ? ((R & ~31) + perm32(R & 31)) : R;
        voffA[i] = (unsigned)(R * K + C) * 2u; voffB[i] = (unsigned)(Rb * K + C) * 2u; }
    const size_t kstep = (size_t)(BK * 2);
    const size_t hstep = (size_t)HALF * K * 2;
    const size_t tstep = 2 * hstep;
    const unsigned ldsw = (unsigned)wid * 1024u;
    const int aoff = lds_byte(wr * 64 + fr, fq * 8), boff = lds_byte(wc * 32 + fr, fq * 8);
#define PG8_SA(b, h) (((b) * 2 + (h)) * HTB)
#define PG8_SB(b, h) ((4 + (b) * 2 + (h)) * HTB)
#define PG8_STAGE(bufoff, gbase, voff) do { _Pragma("unroll") for (int _i = 0; _i < 2; ++_i) \
        __builtin_amdgcn_global_load_lds((const unsigned*)((const char*)(gbase) + (voff)[_i]), (PG8_LAS unsigned*)(lds + (bufoff) + ldsw + _i * 8192), 16, 0, 0); } while (0)
#define PG8_LDA(dst, b, h) do { _Pragma("unroll") for (int m = 0; m < 4; ++m) _Pragma("unroll") for (int k = 0; k < 2; ++k) dst[m][k] = *(const PG8_LAS bf16x8*)(lds + PG8_SA(b, h) + aoff + m * 2048 + k * 1024); } while (0)
#define PG8_LDB(dst, b, h) do { _Pragma("unroll") for (int n = 0; n < 2; ++n) _Pragma("unroll") for (int k = 0; k < 2; ++k) dst[n][k] = *(const PG8_LAS bf16x8*)(lds + PG8_SB(b, h) + boff + n * 2048 + k * 1024); } while (0)
#define PG8_MMA(ai, bj, At, Bt) do { __builtin_amdgcn_s_setprio(1); _Pragma("unroll") for (int m = 0; m < 4; ++m) _Pragma("unroll") for (int n = 0; n < 2; ++n) _Pragma("unroll") for (int k = 0; k < 2; ++k) \
        acc[ai][bj][m][n] = __builtin_amdgcn_mfma_f32_16x16x32_bf16(Bt[n][k], At[m][k], acc[ai][bj][m][n], 0, 0, 0); __builtin_amdgcn_s_setprio(0); } while (0)
#define PG8_WAIT_V(n) asm volatile("s_waitcnt vmcnt(" #n ")" ::: "memory")
#define PG8_WAIT_L(n) asm volatile("s_waitcnt lgkmcnt(" #n ")" ::: "memory")
#define PG8_BAR __builtin_amdgcn_s_barrier()
#define PG8_SCHED __builtin_amdgcn_sched_barrier(0)
    Unit cur, nxt; int ui = 0;
    if (!S.next(0, cur)) return;
    f32x4 acc[2][2][4][2];
#pragma unroll
    for (int a = 0; a < 2; ++a)
#pragma unroll
        for (int b = 0; b < 2; ++b)
#pragma unroll
            for (int m = 0; m < 4; ++m)
#pragma unroll
                for (int n = 0; n < 2; ++n) acc[a][b][m][n] = (f32x4){0.f, 0.f, 0.f, 0.f};
    bf16x8 At[4][2], B0[2][2], B1[2][2];
    const char* cA = (const char*)g.A + (size_t)cur.pm * tstep; const char* cB = (const char*)g.Bt + (size_t)cur.pn * tstep;
    S.a_ready(cur);
    if constexpr (SP2) {
        PG8_STAGE(PG8_SB(0, 0), cB, voffB); PG8_STAGE(PG8_SB(0, 1), cB + hstep, voffB); PG8_STAGE(PG8_SA(0, 0), cA, voffA); PG8_STAGE(PG8_SA(0, 1), cA + hstep, voffA);
        if (wr == 1) PG8_BAR;
        PG8_WAIT_V(2); PG8_BAR;
        PG8_STAGE(PG8_SB(1, 0), cB + kstep, voffB); PG8_STAGE(PG8_SA(1, 0), cA + kstep, voffA); PG8_STAGE(PG8_SB(1, 1), cB + hstep + kstep, voffB);
        PG8_WAIT_V(6); PG8_BAR;
    } else {
        PG8_STAGE(PG8_SB(0, 0), cB, voffB); PG8_STAGE(PG8_SA(0, 0), cA, voffA); PG8_STAGE(PG8_SB(0, 1), cB + hstep, voffB); PG8_STAGE(PG8_SA(0, 1), cA + hstep, voffA);
        if (wr == 1) PG8_BAR;
        PG8_WAIT_V(4); PG8_BAR;
        PG8_STAGE(PG8_SB(1, 0), cB + kstep, voffB); PG8_STAGE(PG8_SA(1, 0), cA + kstep, voffA); PG8_STAGE(PG8_SB(1, 1), cB + hstep + kstep, voffB);
        PG8_WAIT_V(6); PG8_BAR;
    }
    for (;;) {
        const bool has_next = S.next(ui + 1, nxt);
        const char* nA = has_next ? (const char*)g.A + (size_t)nxt.pm * tstep : cA; const char* nB = has_next ? (const char*)g.Bt + (size_t)nxt.pn * tstep : cB;
        for (int t = 0; t < nt; t += 2) {
            const bool last = (t == nt - 2);
            const char* a1 = cA + (size_t)(t + 1) * kstep;
            const char* a2 = last ? nA : cA + (size_t)(t + 2) * kstep; const char* b2 = last ? nB : cB + (size_t)(t + 2) * kstep;
            const char* a3 = a2 + kstep; const char* b3 = b2 + kstep;
            if (last && has_next) S.a_ready(nxt);
            if constexpr (SP2) {
            PG8_LDB(B0, 0, 0); PG8_LDB(B1, 0, 1); PG8_SCHED; PG8_LDA(At, 0, 0); PG8_STAGE(PG8_SA(1, 1), a1 + hstep, voffA);
            PG8_WAIT_V(8); PG8_WAIT_L(0); PG8_BAR; PG8_MMA(0, 0, At, B0); PG8_MMA(0, 1, At, B1); PG8_BAR; PG8_SCHED;
            PG8_LDA(At, 0, 1); PG8_STAGE(PG8_SB(0, 0), b2, voffB); PG8_STAGE(PG8_SB(0, 1), b2 + hstep, voffB); PG8_STAGE(PG8_SA(0, 0), a2, voffA);
            PG8_WAIT_V(8); PG8_WAIT_L(0); PG8_BAR; PG8_MMA(1, 0, At, B0); PG8_MMA(1, 1, At, B1); PG8_BAR; PG8_SCHED;
            PG8_LDB(B0, 1, 0); PG8_LDB(B1, 1, 1); PG8_SCHED; PG8_LDA(At, 1, 0); PG8_STAGE(PG8_SA(0, 1), a2 + hstep, voffA);
            PG8_WAIT_V(8); PG8_WAIT_L(0); PG8_BAR; PG8_MMA(0, 0, At, B0); PG8_MMA(0, 1, At, B1); PG8_BAR; PG8_SCHED;
            PG8_LDA(At, 1, 1); PG8_STAGE(PG8_SB(1, 0), b3, voffB); PG8_STAGE(PG8_SB(1, 1), b3 + hstep, voffB); PG8_STAGE(PG8_SA(1, 0), a3, voffA);
            PG8_WAIT_V(8); PG8_WAIT_L(0); PG8_BAR; PG8_MMA(1, 0, At, B0); PG8_MMA(1, 1, At, B1); PG8_BAR; PG8_SCHED;
            } else {
            PG8_LDB(B0, 0, 0); PG8_SCHED; PG8_LDA(At, 0, 0); PG8_STAGE(PG8_SA(1, 1), a1 + hstep, voffA);
            PG8_WAIT_L(8); PG8_BAR; PG8_WAIT_L(0); PG8_MMA(0, 0, At, B0); PG8_BAR; PG8_SCHED;
            PG8_LDB(B1, 0, 1); PG8_STAGE(PG8_SB(0, 0), b2, voffB);
            PG8_BAR; PG8_WAIT_L(0); PG8_MMA(0, 1, At, B1); PG8_BAR;
            PG8_LDA(At, 0, 1); PG8_STAGE(PG8_SA(0, 0), a2, voffA);
            PG8_BAR; PG8_WAIT_L(0); PG8_MMA(1, 0, At, B0); PG8_BAR; PG8_SCHED;
            PG8_STAGE(PG8_SB(0, 1), b2 + hstep, voffB);
            PG8_WAIT_V(6); PG8_BAR; PG8_MMA(1, 1, At, B1); PG8_BAR;
            PG8_LDB(B0, 1, 0); PG8_SCHED; PG8_LDA(At, 1, 0); PG8_STAGE(PG8_SA(0, 1), a2 + hstep, voffA);
            PG8_WAIT_L(8); PG8_BAR; PG8_WAIT_L(0); PG8_MMA(0, 0, At, B0); PG8_BAR; PG8_SCHED;
            PG8_LDB(B1, 1, 1); PG8_STAGE(PG8_SB(1, 0), b3, voffB);
            PG8_BAR; PG8_WAIT_L(0); PG8_MMA(0, 1, At, B1); PG8_BAR;
            PG8_LDA(At, 1, 1); PG8_STAGE(PG8_SA(1, 0), a3, voffA);
            PG8_BAR; PG8_WAIT_L(0); PG8_MMA(1, 0, At, B0); PG8_BAR; PG8_SCHED;
            PG8_STAGE(PG8_SB(1, 1), b3 + hstep, voffB);
            PG8_WAIT_V(6); PG8_BAR; PG8_MMA(1, 1, At, B1); PG8_BAR;
            }
        }
        if constexpr (ALIGN_EPI) { if (wr == 0) PG8_BAR; }
        if constexpr (!Epi::AFTER_DRAIN) { E(acc, cur, wr, wc, fr, fq); S.done(cur); }
        if (!has_next) break;
#pragma unroll
        for (int a = 0; a < 2; ++a)
#pragma unroll
            for (int b = 0; b < 2; ++b)
#pragma unroll
                for (int m = 0; m < 4; ++m)
#pragma unroll
                    for (int n = 0; n < 2; ++n) acc[a][b][m][n] = (f32x4){0.f, 0.f, 0.f, 0.f};
        cur = nxt; cA = nA; cB = nB; ++ui;
        if constexpr (ALIGN_EPI) { if (wr == 1) PG8_BAR; }
    }
    PG8_WAIT_V(0);
    if constexpr (!ALIGN_EPI) { if (wr == 0) PG8_BAR; }
    PG8_BAR;
    if constexpr (Epi::AFTER_DRAIN) { E.fused(acc, cur, wr, wc, fr, fq, lds, wid, lane); S.done(cur); }
#undef PG8_SA
#undef PG8_SB
#undef PG8_STAGE
#undef PG8_LDA
#undef PG8_LDB
#undef PG8_MMA
#undef PG8_WAIT_V
#undef PG8_WAIT_L
#undef PG8_BAR
#undef PG8_SCHED
}
}
namespace att {
using bf16 = __hip_bfloat16;
constexpr int   D = 128, NW = 8, QBLK = 32, KVBLK = 64;
constexpr float SCALE = 0.088388347648318440f;
constexpr float THR = 8.f;
constexpr int SDEPTH = 2;
constexpr int LDQ = 4608, LDK = 4608, LDO = 2048;
constexpr size_t SHM_V = KVBLK * D * 2, SHM_K = KVBLK * D * 2, SHM_ATTN = 2 * SHM_V + 2 * SHM_K + NW * 64 * 4;
using bf16x8 = __attribute__((ext_vector_type(8))) short;
using s16x4  = __attribute__((ext_vector_type(4))) short;
using f32x16 = __attribute__((ext_vector_type(16))) float;
using f32x8  = __attribute__((ext_vector_type(8))) float;
using u32x4  = __attribute__((ext_vector_type(4))) unsigned;
#define KSWZ(row, colB) ((row) * 256 + ((colB) ^ (((row) & 7) << 4)))
#define SBAR() __builtin_amdgcn_sched_barrier(0)
__device__ __forceinline__ int crow(int r, int hi) { return (r & 3) + 8 * (r >> 2) + 4 * hi; }
__device__ __forceinline__ unsigned cvtpk(float lo, float hi) {
  unsigned r; asm volatile("v_cvt_pk_bf16_f32 %0, %1, %2" : "=v"(r) : "v"(lo), "v"(hi)); return r;
}
template <typename TIn> struct Stage;
template <> struct Stage<bf16>  { using T = bf16x8;
  __device__ static __forceinline__ T ld8(const bf16* p) { return *reinterpret_cast<const bf16x8*>(p); }
  __device__ static __forceinline__ bf16x8 tobf(T x) { return x; } };
template <> struct Stage<float> { using T = f32x8;
  __device__ static __forceinline__ T ld8(const float* p) { return *reinterpret_cast<const f32x8*>(p); }
  __device__ static __forceinline__ bf16x8 tobf(T x) {
    u32x4 w = {cvtpk(x[0], x[1]), cvtpk(x[2], x[3]), cvtpk(x[4], x[5]), cvtpk(x[6], x[7])}; return *reinterpret_cast<bf16x8*>(&w); } };

__device__ __forceinline__ void partialSM(f32x16& p0, f32x16& p1, float& m_reg, float& mn, float& alpha) {
  constexpr float C = SCALE * 1.4426950408889634f;
  float pmax = p0[0]; for (int r = 1; r < 16; ++r) pmax = fmaxf(pmax, p0[r]); for (int r = 0; r < 16; ++r) pmax = fmaxf(pmax, p1[r]);
  { auto rr = __builtin_amdgcn_permlane32_swap(__float_as_uint(pmax), __float_as_uint(pmax), false, false);
    pmax = fmaxf(__uint_as_float(rr[0]), __uint_as_float(rr[1])); }
  if (__builtin_expect(__all(pmax - m_reg <= THR / SCALE), 1)) { mn = m_reg; alpha = 1.f; }
  else { mn = fmaxf(m_reg, pmax); alpha = __builtin_amdgcn_exp2f((m_reg - mn) * C); m_reg = mn; }
  float mnC = -mn * C;
  for (int r = 0; r < 16; ++r) p0[r] = fmaf(p0[r], C, mnC); for (int r = 0; r < 16; ++r) p1[r] = fmaf(p1[r], C, mnC);
  for (int r = 0; r < 16; ++r) p0[r] = __builtin_amdgcn_exp2f(p0[r]);
}
__device__ __forceinline__ void finishSM(f32x16& p0, f32x16& p1, float alpha, float& l_reg, bf16x8& pa0, bf16x8& pa1, bf16x8& pa2, bf16x8& pa3) {
  for (int r = 0; r < 16; ++r) p1[r] = __builtin_amdgcn_exp2f(p1[r]);
  float ps = 0; for (int r = 0; r < 16; ++r) ps += p0[r]; for (int r = 0; r < 16; ++r) ps += p1[r];
  { auto rr = __builtin_amdgcn_permlane32_swap(__float_as_uint(ps), __float_as_uint(ps), false, false);
    ps = __uint_as_float(rr[0]) + __uint_as_float(rr[1]); }
  l_reg = l_reg * alpha + ps;
#define PK4(P, BASE, OUT) do { unsigned a0 = cvtpk(P[BASE + 0], P[BASE + 1]), a1 = cvtpk(P[BASE + 2], P[BASE + 3]);   \
    unsigned b0 = cvtpk(P[BASE + 4], P[BASE + 5]), b1 = cvtpk(P[BASE + 6], P[BASE + 7]);                              \
    auto r0 = __builtin_amdgcn_permlane32_swap(a0, b0, false, false); auto r1 = __builtin_amdgcn_permlane32_swap(a1, b1, false, false); \
    u32x4 w = {r0[0], r1[0], r0[1], r1[1]}; OUT = *reinterpret_cast<bf16x8*>(&w); } while (0)
  PK4(p0, 0, pa0); PK4(p0, 8, pa1); PK4(p1, 0, pa2); PK4(p1, 8, pa3);
#undef PK4
}
__device__ __forceinline__ void qkt(f32x16& p0, f32x16& p1, const bf16* Ks, const bf16x8* qr, int r32, int hi) {
  p0 = f32x16{}; p1 = f32x16{};
  for (int d0 = 0; d0 < 8; ++d0) { int cb = (d0 * 16 + hi * 8) * 2;
    bf16x8 b0 = *reinterpret_cast<const bf16x8*>((const char*)Ks + KSWZ(r32, cb));
    bf16x8 b1 = *reinterpret_cast<const bf16x8*>((const char*)Ks + KSWZ(32 + r32, cb));
    p0 = __builtin_amdgcn_mfma_f32_32x32x16_bf16(b0, qr[d0], p0, 0, 0, 0);
    p1 = __builtin_amdgcn_mfma_f32_32x32x16_bf16(b1, qr[d0], p1, 0, 0, 0); }
}
__device__ __forceinline__ int v_st(int k, int c) { const int kk = (k & ~0xC) | ((k & 4) << 1) | ((k & 8) >> 1); return ((kk >> 3) * 4 + (c >> 5)) * 512 + ((kk & 7) * 32 + (c & 31)) * 2; }
__device__ __forceinline__ int v_rd_base(int lane) { return ((lane & 3) << 3) | (((lane >> 2) & 3) << 6) | (((lane >> 4) & 1) << 5) | (((lane >> 5) & 1) << 8); }
constexpr int v_rd_off(int d0, int ks, int half) { return d0 * 512 + ks * 4096 + half * 2048; }
template <int OFF> __device__ __forceinline__ s16x4 tr_read(int vb) {
  s16x4 r; asm volatile("ds_read_b64_tr_b16 %0, %1 offset:%2" : "=&v"(r) : "v"(vb), "i"(OFF) : "memory"); return r;
}
template <int D0> __device__ __forceinline__ void pv_one(f32x16& od, int vb, bf16x8 pa0, bf16x8 pa1, bf16x8 pa2, bf16x8 pa3) {
  const s16x4 l0 = tr_read<v_rd_off(D0, 0, 0)>(vb), h0 = tr_read<v_rd_off(D0, 0, 1)>(vb), l1 = tr_read<v_rd_off(D0, 1, 0)>(vb), h1 = tr_read<v_rd_off(D0, 1, 1)>(vb);
  const s16x4 l2 = tr_read<v_rd_off(D0, 2, 0)>(vb), h2 = tr_read<v_rd_off(D0, 2, 1)>(vb), l3 = tr_read<v_rd_off(D0, 3, 0)>(vb), h3 = tr_read<v_rd_off(D0, 3, 1)>(vb);
  asm volatile("s_waitcnt lgkmcnt(0)" ::: "memory"); SBAR();
#define PK(L, H) (bf16x8){L[0], L[1], L[2], L[3], H[0], H[1], H[2], H[3]}
  od = __builtin_amdgcn_mfma_f32_32x32x16_bf16(pa0, PK(l0, h0), od, 0, 0, 0);
  od = __builtin_amdgcn_mfma_f32_32x32x16_bf16(pa1, PK(l1, h1), od, 0, 0, 0);
  od = __builtin_amdgcn_mfma_f32_32x32x16_bf16(pa2, PK(l2, h2), od, 0, 0, 0);
  od = __builtin_amdgcn_mfma_f32_32x32x16_bf16(pa3, PK(l3, h3), od, 0, 0, 0);
#undef PK
}
__device__ __forceinline__ void pv_d0(f32x16* o, int vb, bf16x8 pa0, bf16x8 pa1, bf16x8 pa2, bf16x8 pa3) {
  pv_one<0>(o[0], vb, pa0, pa1, pa2, pa3); pv_one<1>(o[1], vb, pa0, pa1, pa2, pa3); pv_one<2>(o[2], vb, pa0, pa1, pa2, pa3); pv_one<3>(o[3], vb, pa0, pa1, pa2, pa3);
}


typedef const __attribute__((address_space(3))) float* lds_cf;
__device__ __forceinline__ void nbmask(f32x16& p0, f32x16& p1, int kr, int rq, int cq, int hi, lds_cf tbl) {
  int r0 = rq - 4; r0 = r0 < 0 ? 0 : (r0 > 248 ? 248 : r0);
  int c0 = cq - 8; c0 = c0 < 0 ? 0 : (c0 > 48 ? 48 : c0);
  const bool row_ok = (unsigned)(kr - r0) < 8u;
  const unsigned long long cm = row_ok ? ((0xFFFFull << c0) >> (4 * hi)) : 0ull;
  const unsigned mlo = (unsigned)cm, mhi = (unsigned)(cm >> 32);
  const int dr = row_ok ? kr - rq + 7 : 0;
  lds_cf tb = tbl + (dr * 128 + 63 - cq + 4 * hi);
#pragma unroll
  for (int r = 0; r < 16; ++r) {
    const int bit = (r & 3) + 8 * (r >> 2);
    float b0 = tb[bit], b1 = tb[bit + 32]; asm volatile("" : "+v"(b0), "+v"(b1));
    p0[r] = (mlo & (1u << bit)) ? p0[r] + b0 : -INFINITY; p1[r] = (mhi & (1u << bit)) ? p1[r] + b1 : -INFINITY;
  }
}
template <bool NB>
__device__ __forceinline__ void attn_dense_body(const bf16* __restrict__ Qb, const bf16* __restrict__ Kh, const bf16* __restrict__ Vh,
                                                bf16* __restrict__ Ob, int seq, char* lds, int tq0, int krow0, int wave_s) {
  using TQ = bf16; constexpr int SDEPTH = NB ? 1 : 2;
  using St = Stage<bf16>; using SQ = Stage<TQ>;
  int tid_ = __builtin_amdgcn_mbcnt_hi(~0u, __builtin_amdgcn_mbcnt_lo(~0u, 0u)); asm volatile("" : "+v"(tid_)); tid_ += wave_s * 64;
  const int tid = tid_, wid = tid >> 6, lane = tid & 63, r32 = lane & 31, hi = lane >> 5;
  bf16* V_lds = (bf16*)lds; bf16* K_lds = (bf16*)(lds + 2 * SHM_V);
  float* ws = (float*)(lds + 2 * SHM_V + 2 * SHM_K) + wid * 64; float* li_l = ws; float* al_l = ws + 32;
  float m_reg = -1e30f, l_reg = 0; f32x16 o[4] = {}; bf16x8 qr[8];
  lds_cf tbl = (lds_cf)(__attribute__((address_space(3))) char*)(lds + SHM_ATTN);
  const int nb_tq = tq0 + wid * QBLK + r32, nb_rq = nb_tq >> 6, nb_cq = nb_tq & 63;
  const TQ* Qw = Qb + (long)(wid * QBLK + r32) * LDQ + hi * 8;
#pragma unroll
  for (int d0 = 0; d0 < 8; ++d0) qr[d0] = SQ::tobf(SQ::ld8(Qw + d0 * 16));
  const int sr = tid >> 4, sc = (tid & 15) * 8, vst0 = v_st(sr, sc), vst1 = v_st(32 + sr, sc);
  const int vb0 = (int)(uintptr_t)V_lds + v_rd_base(lane);
  struct { typename St::T vs0, vs1, ks0, ks1; } sr_[SDEPTH];
#define SLOAD(i, k0) do { sr_[i].vs0 = St::ld8(&Vh[(long)((k0) + sr) * LDK + sc]); sr_[i].vs1 = St::ld8(&Vh[(long)((k0) + 32 + sr) * LDK + sc]); \
    sr_[i].ks0 = St::ld8(&Kh[(long)((k0) + sr) * LDK + sc]); sr_[i].ks1 = St::ld8(&Kh[(long)((k0) + 32 + sr) * LDK + sc]); } while (0)
#define SWRITE(b, i) do { *(bf16x8*)((char*)V_lds + (b) * SHM_V + vst0) = St::tobf(sr_[i].vs0);          \
    *(bf16x8*)((char*)V_lds + (b) * SHM_V + vst1) = St::tobf(sr_[i].vs1); int kc = sc * 2;               \
    *(bf16x8*)((char*)K_lds + (b) * SHM_K + KSWZ(sr, kc)) = St::tobf(sr_[i].ks0);                       \
    *(bf16x8*)((char*)K_lds + (b) * SHM_K + KSWZ(32 + sr, kc)) = St::tobf(sr_[i].ks1); } while (0)
#define SWAIT() do { if constexpr (SDEPTH == 2) asm volatile("s_waitcnt vmcnt(4)" ::: "memory"); else asm volatile("s_waitcnt vmcnt(0)" ::: "memory"); } while (0)
#define RESC(a) do { if (__any((a) < 1.f)) { if (hi == 0) al_l[r32] = (a); asm volatile("s_waitcnt lgkmcnt(0)" ::: "memory"); \
    for (int d = 0; d < 4; ++d) for (int r = 0; r < 16; ++r) o[d][r] *= al_l[crow(r, hi)]; } } while (0)
  f32x16 pA0, pA1, pB0, pB1; float mnA, mnB, alA, alB; bf16x8 pa0, pa1, pa2, pa3; const int NT = seq / KVBLK;
  constexpr int SE = 0, SO = SDEPTH - 1;
  SLOAD(SE, 0); asm volatile("s_waitcnt vmcnt(0)" ::: "memory"); SWRITE(0, SE); __syncthreads();
  qkt(pA0, pA1, K_lds, qr, r32, hi); if constexpr (NB) nbmask(pA0, pA1, krow0, nb_rq, nb_cq, hi, tbl); partialSM(pA0, pA1, m_reg, mnA, alA);
  SLOAD(SO, KVBLK); if constexpr (SDEPTH == 2) { if (2 < NT) SLOAD(SE, 2 * KVBLK); }
  SWAIT(); SWRITE(1, SO); __syncthreads();
  for (int j = 1; j + 1 < NT; j += 2) {
    SBAR(); qkt(pB0, pB1, (bf16*)((char*)K_lds + SHM_K), qr, r32, hi); if constexpr (NB) nbmask(pB0, pB1, krow0 + j, nb_rq, nb_cq, hi, tbl);
    finishSM(pA0, pA1, alA, l_reg, pa0, pa1, pa2, pa3); SBAR();
    SLOAD(SO, (j + SDEPTH) * KVBLK); SBAR();
    pv_d0(o, vb0, pa0, pa1, pa2, pa3); partialSM(pB0, pB1, m_reg, mnB, alB);
    __syncthreads(); SWAIT(); SWRITE(0, SE);
    RESC(alB); __syncthreads();
    SBAR(); qkt(pA0, pA1, K_lds, qr, r32, hi); if constexpr (NB) nbmask(pA0, pA1, krow0 + j + 1, nb_rq, nb_cq, hi, tbl);
    finishSM(pB0, pB1, alB, l_reg, pa0, pa1, pa2, pa3); SBAR();
    if (SDEPTH == 1 || j + 3 < NT) SLOAD(SE, (j + 1 + SDEPTH) * KVBLK); SBAR();
    pv_d0(o, vb0 + (int)SHM_V, pa0, pa1, pa2, pa3); partialSM(pA0, pA1, m_reg, mnA, alA);
    __syncthreads(); SWAIT(); SWRITE(1, SO);
    RESC(alA); __syncthreads();
  }
  SBAR(); qkt(pB0, pB1, (bf16*)((char*)K_lds + SHM_K), qr, r32, hi); if constexpr (NB) nbmask(pB0, pB1, krow0 + NT - 1, nb_rq, nb_cq, hi, tbl);
  finishSM(pA0, pA1, alA, l_reg, pa0, pa1, pa2, pa3); SBAR();
  pv_d0(o, vb0, pa0, pa1, pa2, pa3); partialSM(pB0, pB1, m_reg, mnB, alB);
  __syncthreads(); RESC(alB);
  finishSM(pB0, pB1, alB, l_reg, pa0, pa1, pa2, pa3); SBAR();
  pv_d0(o, vb0 + (int)SHM_V, pa0, pa1, pa2, pa3);
  if (hi == 0) li_l[r32] = l_reg; asm volatile("s_waitcnt lgkmcnt(0)" ::: "memory");
  float rli[16];
#pragma unroll
  for (int r = 0; r < 16; ++r) rli[r] = __builtin_amdgcn_rcpf(li_l[crow(r, hi)]);
  bf16* Ow = Ob + (long)(wid * QBLK) * LDO;
#pragma unroll
  for (int r = 0; r < 16; ++r) { int orow = crow(r, hi);
    for (int d0 = 0; d0 < 4; ++d0) Ow[(long)orow * LDO + d0 * 32 + r32] = __float2bfloat16(o[d0][r] * rli[r]); }
  __syncthreads();
#undef SLOAD
#undef SWRITE
#undef SWAIT
#undef RESC
}

#undef KSWZ
}
#ifndef MK_N_LAUNCHES
#define MK_N_LAUNCHES 1
#endif
constexpr int NWAVES = 8, NTHR = NWAVES * 64;
constexpr int S = 16384, DM = 2048, INW = 4608, DFF = 8192, PLE = 256, NPH = 11;
constexpr float EPS = 1e-6f;
typedef unsigned short bf16r;
typedef float f32x4 __attribute__((ext_vector_type(4)));
typedef unsigned v4u __attribute__((ext_vector_type(4)));
typedef unsigned v2u __attribute__((ext_vector_type(2)));
#define LAS __attribute__((address_space(3)))
constexpr size_t MiB = 1u << 20;
constexpr size_t WS_WIN = 1 * MiB, WS_WO = 19 * MiB, WS_WUP = 27 * MiB, WS_WDN = 59 * MiB, WS_WG = 91 * MiB, WS_WP = 99 * MiB;
constexpr size_t WS_PBF = 100 * MiB;
constexpr size_t WS_A = 108 * MiB;
constexpr size_t WS_B = 364 * MiB;
constexpr size_t WS_END = 492 * MiB;
constexpr int LDS_BYTES = 147456;

__device__ __forceinline__ unsigned f2bf(float f) { unsigned u = __builtin_bit_cast(unsigned, f); return (u + 0x7fffu + ((u >> 16) & 1u)) >> 16; }
__device__ __forceinline__ unsigned pk2(float lo, float hi) { return f2bf(lo) | (f2bf(hi) << 16); }
__device__ __forceinline__ float bf2f(unsigned short b) { return __builtin_bit_cast(float, (unsigned)b << 16); }
__device__ __forceinline__ float wave_sum(float v) {
#pragma unroll
    for (int o = 1; o < 64; o <<= 1) v += __shfl_xor(v, o);
    return v;
}
__device__ __forceinline__ void p0_transpose_item(const float* __restrict__ W, int K, int N, bf16r* __restrict__ WT, LAS float* scr, int item, int lane) {
    const int nblk = N / 32, kb = item / nblk, nb = item % nblk, k0 = 64 * kb, n0 = 32 * nb;
#pragma unroll 8
    for (int i = 0; i < 32; ++i) { const int kk = 2 * i + (lane >> 5); scr[kk * 33 + (lane & 31)] = W[(size_t)(k0 + kk) * N + n0 + (lane & 31)]; }
    asm volatile("s_waitcnt lgkmcnt(0)" ::: "memory");
    const int c = lane & 7;
#pragma unroll
    for (int j = 0; j < 4; ++j) { const int n = (lane >> 3) + 8 * j; const LAS float* s = scr + (8 * c) * 33 + n;
        v4u o; o.x = pk2(s[0 * 33], s[1 * 33]); o.y = pk2(s[2 * 33], s[3 * 33]); o.z = pk2(s[4 * 33], s[5 * 33]); o.w = pk2(s[6 * 33], s[7 * 33]);
        *(v4u*)(WT + (size_t)(n0 + n) * K + k0 + 8 * c) = o; }
    asm volatile("s_waitcnt lgkmcnt(0)" ::: "memory");
}
__device__ __forceinline__ void row_norm_bf16(const float* __restrict__ xrow, const float* __restrict__ g, bf16r* __restrict__ orow, int lane) {
    const f32x4* xr = (const f32x4*)xrow + lane; const f32x4* gr = (const f32x4*)g + lane;
    f32x4 v[8]; float s = 0.f;
#pragma unroll
    for (int j = 0; j < 8; ++j) { v[j] = xr[64 * j]; s += (v[j].x * v[j].x + v[j].y * v[j].y) + (v[j].z * v[j].z + v[j].w * v[j].w); }
    const float rs = rsqrtf(wave_sum(s) * (1.f / DM) + EPS);
    v2u* o8 = (v2u*)orow + lane;
#pragma unroll
    for (int j = 0; j < 8; ++j) { const f32x4 gj = gr[64 * j]; v2u w; w.x = pk2(v[j].x * rs * gj.x, v[j].y * rs * gj.y); w.y = pk2(v[j].z * rs * gj.z, v[j].w * rs * gj.w); o8[64 * j] = w; }
}
template <bool XN>
__device__ __forceinline__ void row_res_norm(const float* res, const float* __restrict__ trow, const float* __restrict__ gpost, const float* __restrict__ gpre,
                                             float* hout, bf16r* __restrict__ xnout, int lane) {
    const f32x4* tr = (const f32x4*)trow + lane; const f32x4* rr = (const f32x4*)res + lane; const f32x4* gp = (const f32x4*)gpost + lane;
    f32x4 t[8], h[8]; float s = 0.f;
#pragma unroll
    for (int j = 0; j < 8; ++j) { t[j] = tr[64 * j]; h[j] = rr[64 * j]; s += (t[j].x * t[j].x + t[j].y * t[j].y) + (t[j].z * t[j].z + t[j].w * t[j].w); }
    const float rs = rsqrtf(wave_sum(s) * (1.f / DM) + EPS);
    float s2 = 0.f; f32x4* ho = (f32x4*)hout + lane;
#pragma unroll
    for (int j = 0; j < 8; ++j) { const f32x4 gj = gp[64 * j]; h[j] = h[j] + t[j] * rs * gj; ho[64 * j] = h[j];
        s2 += (h[j].x * h[j].x + h[j].y * h[j].y) + (h[j].z * h[j].z + h[j].w * h[j].w); }
    if constexpr (XN) {
        const float rs2 = rsqrtf(wave_sum(s2) * (1.f / DM) + EPS);
        const f32x4* gq = (const f32x4*)gpre + lane; v2u* o8 = (v2u*)xnout + lane;
#pragma unroll
        for (int j = 0; j < 8; ++j) { const f32x4 gj = gq[64 * j]; v2u w; w.x = pk2(h[j].x * rs2 * gj.x, h[j].y * rs2 * gj.y); w.y = pk2(h[j].z * rs2 * gj.z, h[j].w * rs2 * gj.w); o8[64 * j] = w; }
    }
}

#define A_X        (args.in[0])
#define A_P        (args.in[1])
#define A_GPREMIX  (args.in[2])
#define A_WIN      (args.in[3])
#define A_GQ       (args.in[4])
#define A_GK       (args.in[5])
#define A_RPB      (args.in[6])
#define A_WO       (args.in[7])
#define A_GPOSTMIX (args.in[8])
#define A_GPREMLP  (args.in[9])
#define A_WUP      (args.in[10])
#define A_WDN      (args.in[11])
#define A_GPOSTMLP (args.in[12])
#define A_GPREPLE  (args.in[13])
#define A_WGATE    (args.in[14])
#define A_WPLE     (args.in[15])
#define A_GPOSTPLE (args.in[16])
#define W_(off)    (args.ws + (off))
struct Args { const float* in[17]; float* out; unsigned char* ws; int ph_lo, ph_hi; };

__global__ void __launch_bounds__(NTHR, 2) mega_fwd(Args args) {
    extern __shared__ __attribute__((aligned(16))) unsigned char lds[];
    const int G = gridDim.x, bx = blockIdx.x, NGW = G * NWAVES;
    const int wave_s = __builtin_amdgcn_readfirstlane((int)threadIdx.x >> 6);
#define LANEVARS int lane_ = __builtin_amdgcn_mbcnt_hi(~0u, __builtin_amdgcn_mbcnt_lo(~0u, 0u)); asm volatile("" : "+v"(lane_)); const int lane = lane_, wave = wave_s, tid = wave * 64 + lane, gw = bx * NWAVES + wave; (void)lane; (void)gw; (void)tid;
    const int lo = args.ph_lo, hi = args.ph_hi;
#ifdef ONLY_PHASE
#define IN(k) ((k) == ONLY_PHASE && lo <= (k) && (k) < hi)
#else
#define IN(k) (lo <= (k) && (k) < hi)
#endif
#define SEAM(k) do { if (IN(k) && IN((k) + 1)) { cg::this_grid().sync(); } } while (0)
    LAS unsigned char* ldsl = (LAS unsigned char*)lds;

    if (IN(0)) {
        LANEVARS
        LAS float* scr = (LAS float*)(ldsl + wave * 16384);
        constexpr int I_IN = (DM / 64) * (INW / 32), I_O = (DM / 64) * (DM / 32), I_UP = (DM / 64) * (DFF / 32), I_DN = (DFF / 64) * (DM / 32), I_G = I_O, I_P = (PLE / 64) * (DM / 32);
        constexpr int NITEMS = I_IN + I_O + I_UP + I_DN + I_G + I_P;
        for (int it = gw; it < NITEMS; it += NGW) {
            int r = it;
            if (r < I_IN) { p0_transpose_item(A_WIN, DM, INW, (bf16r*)W_(WS_WIN), scr, r, lane); continue; } r -= I_IN;
            if (r < I_O) { p0_transpose_item(A_WO, DM, DM, (bf16r*)W_(WS_WO), scr, r, lane); continue; } r -= I_O;
            if (r < I_UP) { p0_transpose_item(A_WUP, DM, DFF, (bf16r*)W_(WS_WUP), scr, r, lane); continue; } r -= I_UP;
            if (r < I_DN) { p0_transpose_item(A_WDN, DFF, DM, (bf16r*)W_(WS_WDN), scr, r, lane); continue; } r -= I_DN;
            if (r < I_G) { p0_transpose_item(A_WGATE, DM, DM, (bf16r*)W_(WS_WG), scr, r, lane); continue; } r -= I_G;
            p0_transpose_item(A_WPLE, PLE, DM, (bf16r*)W_(WS_WP), scr, r, lane);
        }
        for (int m = gw; m < S; m += NGW) row_norm_bf16(A_X + (size_t)m * DM, A_GPREMIX, (bf16r*)W_(WS_B) + (size_t)m * DM, lane);
        for (size_t i = (size_t)bx * NTHR + tid; i < (size_t)S * PLE / 8; i += (size_t)G * NTHR) {
            const f32x4 a = ((const f32x4*)A_P)[2 * i], b = ((const f32x4*)A_P)[2 * i + 1];
            v4u o; o.x = pk2(a.x, a.y); o.y = pk2(a.z, a.w); o.z = pk2(b.x, b.y); o.w = pk2(b.z, b.w); ((v4u*)W_(WS_PBF))[i] = o; }
        __syncthreads();
    }
    SEAM(0);
    if (IN(1)) {
        pg8::Gemm g{(const bf16r*)W_(WS_B), (const bf16r*)W_(WS_WIN), S, INW, DM}; pg8::StaticOrder So; So.init(S, INW, G, bx);
        pg8::EpiBf16<0> E{(bf16r*)W_(WS_A), INW};
        pg8::gemm_phase<pg8::EpiBf16<0>, pg8::StaticOrder, true, true>(ldsl, g, So, E, wave_s);
    }
    SEAM(1);
    if (IN(2)) {
        LANEVARS
        const int half = lane >> 5, i = lane & 31;
        const float freq = exp2f(-(float)i * (13.287712379549449f / 32.f));
        const float gq1 = A_GQ[half * 64 + i], gq2 = A_GQ[half * 64 + 32 + i], gk1 = A_GK[half * 64 + i], gk2 = A_GK[half * 64 + 32 + i]; bf16r* PROJ = (bf16r*)W_(WS_A);
        for (int it = gw; it < S * 10; it += NGW) {
            const int t = it / 10, hd = it - t * 10;
            bf16r* ptr = PROJ + (size_t)t * INW + hd * 128 + half * 64;
            const float x1 = bf2f(ptr[i]), x2 = bf2f(ptr[32 + i]);
            const float rs = rsqrtf(wave_sum(x1 * x1 + x2 * x2) * (1.f / 128.f) + EPS);
            const float y1 = x1 * rs * (hd < 8 ? gq1 : gk1), y2 = x2 * rs * (hd < 8 ? gq2 : gk2);
            const int pos = half ? (t & 63) : (t >> 6);
            const float ang = (float)pos * freq;
            double rev = (double)ang * 0.15915494309189535; rev -= floor(rev);
            const float fr = (float)rev; const float sn = __builtin_amdgcn_sinf(fr), cs = __builtin_amdgcn_cosf(fr);
            ptr[i] = (bf16r)f2bf(y1 * cs - y2 * sn); ptr[32 + i] = (bf16r)f2bf(y2 * cs + y1 * sn);
        }
    }
    SEAM(2);
    if (IN(3)) {
        LANEVARS
        char* al = (char*)lds; const bf16r* PROJ = (const bf16r*)W_(WS_A); bf16r* ATT = (bf16r*)W_(WS_A + 144 * MiB); const float* rpb = A_RPB;
#ifndef ATT_NO_A
        for (int u = bx; u < 512; u += G) {
            const int h = u >> 6, qb = u & 63, kvh = h >> 2;
            const att::bf16* Q = (const att::bf16*)PROJ + (size_t)(qb * 256) * INW + h * 128;
            const att::bf16* K = (const att::bf16*)PROJ + 1024 + kvh * 128; const att::bf16* V = (const att::bf16*)PROJ + 1280 + kvh * 128;
            att::attn_dense_body<false>(Q, K, V, (att::bf16*)ATT + (size_t)(qb * 256) * DM + h * 128, S, al, 0, 0, wave_s);
        }
#endif
#ifndef ATT_NO_B
        for (int u = bx; u < 512; u += G) {
            const int h = u >> 6, qb = u & 63, R = qb * 4, rs = R - 4 < 0 ? 0 : R - 4, re = R + 8 > 256 ? 256 : R + 8;
            LAS float* tbl = (LAS float*)(ldsl + att::SHM_ATTN);
            for (int i = tid; i < 15 * 128; i += NTHR) { const int dr = i >> 7, dc = (i & 127) - 48; tbl[i] = (dc >= 0 && dc < 31) ? rpb[h * 465 + dr * 31 + dc] * (1.f / att::SCALE) : 0.f; }
            __syncthreads();
            const att::bf16* Q = (const att::bf16*)PROJ + (size_t)(qb * 256) * INW + 1536 + h * 128;
            const att::bf16* K = (const att::bf16*)PROJ + (size_t)(rs * 64) * INW + 2560 + h * 128; const att::bf16* V = K + 1024;
            att::attn_dense_body<true>(Q, K, V, (att::bf16*)ATT + (size_t)(qb * 256) * DM + 1024 + h * 128, (re - rs) * 64, al, qb * 256, rs, wave_s);
        }
#endif
    }
    SEAM(3);
    if (IN(4)) {
        pg8::Gemm g{(const bf16r*)W_(WS_A + 144 * MiB), (const bf16r*)W_(WS_WO), S, DM, DM}; pg8::StaticOrder So; So.init(S, DM, G, bx);
        pg8::EpiF32<0> E{(float*)W_(WS_A), DM};
        pg8::gemm_phase<pg8::EpiF32<0>, pg8::StaticOrder, true, true>(ldsl, g, So, E, wave_s);
    }
    SEAM(4);
    if (IN(5)) {
        LANEVARS
        for (int m = gw; m < S; m += NGW) row_res_norm<true>(A_X + (size_t)m * DM, (const float*)W_(WS_A) + (size_t)m * DM, A_GPOSTMIX, A_GPREMLP, args.out + (size_t)m * DM, (bf16r*)W_(WS_B) + (size_t)m * DM, lane);
    }
    SEAM(5);
    if (IN(6)) {
        pg8::Gemm g{(const bf16r*)W_(WS_B), (const bf16r*)W_(WS_WUP), S, DFF, DM}; pg8::StaticOrder So; So.init(S, DFF, G, bx);
        pg8::EpiBf16<2> E{(bf16r*)W_(WS_A), DFF};
        pg8::gemm_phase<pg8::EpiBf16<2>, pg8::StaticOrder, true, true>(ldsl, g, So, E, wave_s);
    }
    SEAM(6);
    if (IN(7)) {
        pg8::Gemm g{(const bf16r*)W_(WS_A), (const bf16r*)W_(WS_WDN), S, DM, DFF}; pg8::StaticOrder So; So.init(S, DM, G, bx);
        pg8::EpiF32<0> E{(float*)W_(WS_B), DM};
        pg8::gemm_phase<pg8::EpiF32<0>, pg8::StaticOrder, true, true>(ldsl, g, So, E, wave_s);
    }
    SEAM(7);
    if (IN(8)) {
        LANEVARS
        for (int m = gw; m < S; m += NGW) row_res_norm<true>(args.out + (size_t)m * DM, (const float*)W_(WS_B) + (size_t)m * DM, A_GPOSTMLP, A_GPREPLE, args.out + (size_t)m * DM, (bf16r*)W_(WS_A) + (size_t)m * DM, lane);
        __syncthreads();
        pg8::Gemm g{(const bf16r*)W_(WS_PBF), (const bf16r*)W_(WS_WP), S, DM, PLE}; pg8::StaticOrder So; So.init(S, DM, G, bx);
        pg8::EpiF32<0> E{(float*)W_(WS_A + 64 * MiB), DM};
        pg8::gemm_phase<pg8::EpiF32<0>, pg8::StaticOrder, true, true>(ldsl, g, So, E, wave_s);
    }
    SEAM(8);
    if (IN(9)) {
        pg8::Gemm g{(const bf16r*)W_(WS_A), (const bf16r*)W_(WS_WG), S, DM, DM}; pg8::StaticOrder So; So.init(S, DM, G, bx);
        pg8::EpiF32<1> E{(float*)W_(WS_A + 64 * MiB), DM};
        pg8::gemm_phase<pg8::EpiF32<1>, pg8::StaticOrder, true, true>(ldsl, g, So, E, wave_s);
    }
    SEAM(9);
    if (IN(10)) {
        LANEVARS
        for (int m = gw; m < S; m += NGW) row_res_norm<false>(args.out + (size_t)m * DM, (const float*)W_(WS_A + 64 * MiB) + (size_t)m * DM, A_GPOSTPLE, nullptr, args.out + (size_t)m * DM, nullptr, lane);
    }
#undef IN
#undef SEAM
}

extern "C" void kernel_launch(void* const* d_in, const int* in_sizes, int n_in, void* d_out, int out_size, void* d_ws, size_t ws_size, hipStream_t stream) {
    static int grid = 0;
    if (grid == 0) {
        if (n_in != 17 || in_sizes[0] != S * DM || out_size != S * DM || ws_size < WS_END) {
            fprintf(stderr, "kernel_launch: shape/workspace mismatch: n_in %d in0 %d out %d ws %zu (need %zu)\n", n_in, n_in > 0 ? in_sizes[0] : -1, out_size, ws_size, (size_t)WS_END); grid = -1; return; }
        int dev = 0, cus = 0, per_cu = 0;
        if (hipGetDevice(&dev) != hipSuccess || hipDeviceGetAttribute(&cus, hipDeviceAttributeMultiprocessorCount, dev) != hipSuccess) { grid = -1; return; }
        if (hipFuncSetAttribute((const void*)mega_fwd, hipFuncAttributeMaxDynamicSharedMemorySize, LDS_BYTES) != hipSuccess) { fprintf(stderr, "kernel_launch: hipFuncSetAttribute failed\n"); grid = -1; return; }
        if (hipOccupancyMaxActiveBlocksPerMultiprocessor(&per_cu, (const void*)mega_fwd, NTHR, LDS_BYTES) != hipSuccess || per_cu < 1) per_cu = 1;
        (void)hipGetLastError();
        grid = cus * (per_cu > 1 ? 1 : per_cu);
    }
    if (grid < 0) return;
    Args a{};
    for (int i = 0; i < 17; ++i) a.in[i] = (const float*)d_in[i];
    a.out = (float*)d_out; a.ws = (unsigned char*)d_ws;
    if (MK_N_LAUNCHES == 1) {
        a.ph_lo = 0; a.ph_hi = NPH; void* kargs[] = {&a};
        hipError_t e = hipLaunchCooperativeKernel((const void*)mega_fwd, dim3(grid), dim3(NTHR), kargs, LDS_BYTES, stream);
        if (e != hipSuccess) fprintf(stderr, "kernel_launch: cooperative launch failed: %s (grid %d)\n", hipGetErrorString(e), grid);
    } else {
        for (int k = 0; k < NPH; ++k) { a.ph_lo = k; a.ph_hi = k + 1; hipLaunchKernelGGL(mega_fwd, dim3(grid), dim3(NTHR), LDS_BYTES, stream, a); }
    }
}
```

```cpp
#include <hip/hip_runtime.h>
#include <hip/hip_bf16.h>
#include <hip/hip_cooperative_groups.h>
#include <cstdio>
#include <cstdint>
#include <cmath>
namespace cg = cooperative_groups;
namespace pg8 {
#define PG8_LAS __attribute__((address_space(3)))
typedef unsigned short bf16_t;
typedef short bf16x8 __attribute__((ext_vector_type(8)));
typedef float f32x4 __attribute__((ext_vector_type(4)));
typedef unsigned u32x4 __attribute__((ext_vector_type(4)));
constexpr int BM = 256, BK = 64, HALF = 128, HTB = HALF * BK * 2  , STAGE_BYTES = 8 * HTB, NXCD = 8, WGM = 8;

__host__ __device__ __forceinline__ int lds_byte(int r, int c) { const int st = (r >> 4) * 2 + (c >> 5), rr = r & 15, cc = c & 31, ob = rr * 64 + cc * 2; return st * 1024 + (ob ^ (((ob >> 9) & 1) << 5)); }
__host__ __device__ __forceinline__ void stage_rc(int b, int& R, int& C) { const int st = b / 1024, sb = b % 1024, swz = sb ^ (((sb >> 9) & 1) << 5); R = (st >> 1) * 16 + swz / 64; C = (st & 1) * 32 + (swz % 64) / 2; }
__host__ __device__ __forceinline__ int perm32(int rho) { const int n = rho >> 4, i = rho & 15; return 8 * (i >> 2) + 4 * n + (i & 3); }

struct Unit { int pm, pn; };
struct Gemm { const bf16_t* A; const bf16_t* Bt; int M, N, K; };

struct StaticOrder {
    int nM, nN, nwg, G, c;
    __host__ __device__ void init(int M, int N, int G_, int c_) { nM = M / BM; nN = N / BM; nwg = nM * nN; G = G_; c = c_; }
    __host__ __device__ bool next(int i, Unit& u) const {
        const long L = (long)i * G + c; if (L >= nwg) return false;
        int wgid = (int)L; { const int q = nwg / NXCD, r = nwg % NXCD, xcd = wgid % NXCD, off = wgid / NXCD; wgid = (xcd < r ? xcd * (q + 1) : r * (q + 1) + (xcd - r) * q) + off; }
        const int nig = WGM * nN, gid = wgid / nig, fm = gid * WGM, gsz = (nM - fm) < WGM ? (nM - fm) : WGM;
        u.pm = fm + ((wgid % nig) % gsz); u.pn = (wgid % nig) / gsz; return true;
    }
    __device__ __forceinline__ void a_ready(const Unit&) const {}
    __device__ __forceinline__ void done(const Unit&) const {}
};

__device__ __forceinline__ unsigned cvt_pk_bf16(float lo, float hi) { unsigned r; asm volatile("v_cvt_pk_bf16_f32 %0, %1, %2" : "=v"(r) : "v"(lo), "v"(hi)); return r; }
template <int ACT  > struct EpiBf16 {
    static constexpr bool PERM = true, AFTER_DRAIN = false;
    bf16_t* O; int ldc;
    __device__ __forceinline__ void operator()(const f32x4 (&acc)[2][2][4][2], const Unit& u, int wr, int wc, int fr, int fq) const {
        const int row0 = u.pm * BM + wr * 64 + fr; const int col0 = u.pn * BM + wc * 32 + 8 * fq;
#pragma unroll
        for (int ai = 0; ai < 2; ++ai)
#pragma unroll
            for (int m = 0; m < 4; ++m) { bf16_t* rowp = O + (size_t)(row0 + ai * HALF + m * 16) * ldc + col0;
#pragma unroll
                for (int bj = 0; bj < 2; ++bj) { f32x4 v0 = acc[ai][bj][m][0], v1 = acc[ai][bj][m][1];
                    if (ACT == 2) {
#pragma unroll
                        for (int e = 0; e < 4; ++e) { float a = fmaxf(v0[e], 0.f), b = fmaxf(v1[e], 0.f); v0[e] = a * a; v1[e] = b * b; } }
                    u32x4 w; w.x = cvt_pk_bf16(v0[0], v0[1]); w.y = cvt_pk_bf16(v0[2], v0[3]); w.z = cvt_pk_bf16(v1[0], v1[1]); w.w = cvt_pk_bf16(v1[2], v1[3]);
                    *(u32x4*)(rowp + bj * HALF) = w; } }
    }
};
template <int MODE  > struct EpiF32 {
    static constexpr bool PERM = false, AFTER_DRAIN = false;
    float* C; int ldc;
    __device__ __forceinline__ void operator()(const f32x4 (&acc)[2][2][4][2], const Unit& u, int wr, int wc, int fr, int fq) const {
        const int row0 = u.pm * BM + wr * 64 + fr, col0 = u.pn * BM + wc * 32 + 4 * fq;
#pragma unroll
        for (int ai = 0; ai < 2; ++ai)
#pragma unroll
            for (int m = 0; m < 4; ++m) { float* rowp = C + (size_t)(row0 + ai * HALF + m * 16) * ldc + col0;
#pragma unroll
                for (int bj = 0; bj < 2; ++bj)
#pragma unroll
                    for (int n = 0; n < 2; ++n) {
                        f32x4 v = acc[ai][bj][m][n];
                        if (MODE == 1) { const f32x4 e = *(const f32x4*)(rowp + bj * HALF + n * 16);
#pragma unroll
                            for (int k = 0; k < 4; ++k) v[k] = e[k] * __builtin_amdgcn_rcpf(1.f + __expf(-v[k])); }
                        *(f32x4*)(rowp + bj * HALF + n * 16) = v; } }
    }
};

template <class Epi, class Sched, bool ALIGN_EPI = false, bool SP2 = false>
__device__ __forceinline__ void gemm_phase(PG8_LAS unsigned char* lds, const Gemm g, const Sched& S, const Epi& E, int wave_s) {
    int lane_ = __builtin_amdgcn_mbcnt_hi(~0u, __builtin_amdgcn_mbcnt_lo(~0u, 0u)); asm volatile("" : "+v"(lane_));
    const int tid = wave_s * 64 + lane_, wid = __builtin_amdgcn_readfirstlane(tid >> 6), lane = tid & 63, wr = wid >> 2, wc = wid & 3, fr = lane & 15, fq = lane >> 4;
    const int K = g.K, nt = K / BK;
    unsigned voffA[2], voffB[2];
#pragma unroll
    for (int i = 0; i < 2; ++i) { int R, C; stage_rc(tid * 16 + i * 8192, R, C); const int Rb = Epi::PERM ? ((R & ~31) + perm32(R & 31)) : R;
        voffA[i] = (unsigned)(R * K + C) * 2u; voffB[i] = (unsigned)(Rb * K + C) * 2u; }
    const size_t kstep = (size_t)(BK * 2);
    const size_t hstep = (size_t)HALF * K * 2;
    const size_t tstep = 2 * hstep;
    const unsigned ldsw = (unsigned)wid * 1024u;
    const int aoff = lds_byte(wr * 64 + fr, fq * 8), boff = lds_byte(wc * 32 + fr, fq * 8);
#define PG8_SA(b, h) (((b) * 2 + (h)) * HTB)
#define PG8_SB(b, h) ((4 + (b) * 2 + (h)) * HTB)
#define PG8_STAGE(bufoff, gbase, voff) do { _Pragma("unroll") for (int _i = 0; _i < 2; ++_i) \
        __builtin_amdgcn_global_load_lds((const unsigned*)((const char*)(gbase) + (voff)[_i]), (PG8_LAS unsigned*)(lds + (bufoff) + ldsw + _i * 8192), 16, 0, 0); } while (0)
#define PG8_LDA(dst, b, h) do { _Pragma("unroll") for (int m = 0; m < 4; ++m) _Pragma("unroll") for (int k = 0; k < 2; ++k) dst[m][k] = *(const PG8_LAS bf16x8*)(lds + PG8_SA(b, h) + aoff + m * 2048 + k * 1024); } while (0)
#define PG8_LDB(dst, b, h) do { _Pragma("unroll") for (int n = 0; n < 2; ++n) _Pragma("unroll") for (int k = 0; k < 2; ++k) dst[n][k] = *(const PG8_LAS bf16x8*)(lds + PG8_SB(b, h) + boff + n * 2048 + k * 1024); } while (0)
#define PG8_MMA(ai, bj, At, Bt) do { __builtin_amdgcn_s_setprio(1); _Pragma("unroll") for (int m = 0; m < 4; ++m) _Pragma("unroll") for (int n = 0; n < 2; ++n) _Pragma("unroll") for (int k = 0; k < 2; ++k) \
        acc[ai][bj][m][n] = __builtin_amdgcn_mfma_f32_16x16x32_bf16(Bt[n][k], At[m][k], acc[ai][bj][m][n], 0, 0, 0); __builtin_amdgcn_s_setprio(0); } while (0)
#define PG8_WAIT_V(n) asm volatile("s_waitcnt vmcnt(" #n ")" ::: "memory")
#define PG8_WAIT_L(n) asm volatile("s_waitcnt lgkmcnt(" #n ")" ::: "memory")
#define PG8_BAR __builtin_amdgcn_s_barrier()
#define PG8_SCHED __builtin_amdgcn_sched_barrier(0)
    Unit cur, nxt; int ui = 0;
    if (!S.next(0, cur)) return;
    f32x4 acc[2][2][4][2];
#pragma unroll
    for (int a = 0; a < 2; ++a)
#pragma unroll
        for (int b = 0; b < 2; ++b)
#pragma unroll
            for (int m = 0; m < 4; ++m)
#pragma unroll
                for (int n = 0; n < 2; ++n) acc[a][b][m][n] = (f32x4){0.f, 0.f, 0.f, 0.f};
    bf16x8 At[4][2], B0[2][2], B1[2][2];
    const char* cA = (const char*)g.A + (size_t)cur.pm * tstep; const char* cB = (const char*)g.Bt + (size_t)cur.pn * tstep;
    S.a_ready(cur);
    if constexpr (SP2) {
        PG8_STAGE(PG8_SB(0, 0), cB, voffB); PG8_STAGE(PG8_SB(0, 1), cB + hstep, voffB); PG8_STAGE(PG8_SA(0, 0), cA, voffA); PG8_STAGE(PG8_SA(0, 1), cA + hstep, voffA);
        if (wr == 1) PG8_BAR;
        PG8_WAIT_V(2); PG8_BAR;
        PG8_STAGE(PG8_SB(1, 0), cB + kstep, voffB); PG8_STAGE(PG8_SA(1, 0), cA + kstep, voffA); PG8_STAGE(PG8_SB(1, 1), cB + hstep + kstep, voffB);
        PG8_WAIT_V(6); PG8_BAR;
    } else {
        PG8_STAGE(PG8_SB(0, 0), cB, voffB); PG8_STAGE(PG8_SA(0, 0), cA, voffA); PG8_STAGE(PG8_SB(0, 1), cB + hstep, voffB); PG8_STAGE(PG8_SA(0, 1), cA + hstep, voffA);
        if (wr == 1) PG8_BAR;
        PG8_WAIT_V(4); PG8_BAR;
        PG8_STAGE(PG8_SB(1, 0), cB + kstep, voffB); PG8_STAGE(PG8_SA(1, 0), cA + kstep, voffA); PG8_STAGE(PG8_SB(1, 1), cB + hstep + kstep, voffB);
        PG8_WAIT_V(6); PG8_BAR;
    }
    for (;;) {
        const bool has_next = S.next(ui + 1, nxt);
        const char* nA = has_next ? (const char*)g.A + (size_t)nxt.pm * tstep : cA; const char* nB = has_next ? (const char*)g.Bt + (size_t)nxt.pn * tstep : cB;
        for (int t = 0; t < nt; t += 2) {
            const bool last = (t == nt - 2);
            const char* a1 = cA + (size_t)(t + 1) * kstep;
            const char* a2 = last ? nA : cA + (size_t)(t + 2) * kstep; const char* b2 = last ? nB : cB + (size_t)(t + 2) * kstep;
            const char* a3 = a2 + kstep; const char* b3 = b2 + kstep;
            if (last && has_next) S.a_ready(nxt);
            if constexpr (SP2) {
            PG8_LDB(B0, 0, 0); PG8_LDB(B1, 0, 1); PG8_SCHED; PG8_LDA(At, 0, 0); PG8_STAGE(PG8_SA(1, 1), a1 + hstep, voffA);
            PG8_WAIT_V(8); PG8_WAIT_L(0); PG8_BAR; PG8_MMA(0, 0, At, B0); PG8_MMA(0, 1, At, B1); PG8_BAR; PG8_SCHED;
            PG8_LDA(At, 0, 1); PG8_STAGE(PG8_SB(0, 0), b2, voffB); PG8_STAGE(PG8_SB(0, 1), b2 + hstep, voffB); PG8_STAGE(PG8_SA(0, 0), a2, voffA);
            PG8_WAIT_V(8); PG8_WAIT_L(0); PG8_BAR; PG8_MMA(1, 0, At, B0); PG8_MMA(1, 1, At, B1); PG8_BAR; PG8_SCHED;
            PG8_LDB(B0, 1, 0); PG8_LDB(B1, 1, 1); PG8_SCHED; PG8_LDA(At, 1, 0); PG8_STAGE(PG8_SA(0, 1), a2 + hstep, voffA);
            PG8_WAIT_V(8); PG8_WAIT_L(0); PG8_BAR; PG8_MMA(0, 0, At, B0); PG8_MMA(0, 1, At, B1); PG8_BAR; PG8_SCHED;
            PG8_LDA(At, 1, 1); PG8_STAGE(PG8_SB(1, 0), b3, voffB); PG8_STAGE(PG8_SB(1, 1), b3 + hstep, voffB); PG8_STAGE(PG8_SA(1, 0), a3, voffA);
            PG8_WAIT_V(8); PG8_WAIT_L(0); PG8_BAR; PG8_MMA(1, 0, At, B0); PG8_MMA(1, 1, At, B1); PG8_BAR; PG8_SCHED;
            } else {
            PG8_LDB(B0, 0, 0); PG8_SCHED; PG8_LDA(At, 0, 0); PG8_STAGE(PG8_SA(1, 1), a1 + hstep, voffA);
            PG8_WAIT_L(8); PG8_BAR; PG8_WAIT_L(0); PG8_MMA(0, 0, At, B0); PG8_BAR; PG8_SCHED;
            PG8_LDB(B1, 0, 1); PG8_STAGE(PG8_SB(0, 0), b2, voffB);
            PG8_BAR; PG8_WAIT_L(0); PG8_MMA(0, 1, At, B1); PG8_BAR;
            PG8_LDA(At, 0, 1); PG8_STAGE(PG8_SA(0, 0), a2, voffA);
            PG8_BAR; PG8_WAIT_L(0); PG8_MMA(1, 0, At, B0); PG8_BAR; PG8_SCHED;
            PG8_STAGE(PG8_SB(0, 1), b2 + hstep, voffB);
            PG8_WAIT_V(6); PG8_BAR; PG8_MMA(1, 1, At, B1); PG8_BAR;
            PG8_LDB(B0, 1, 0); PG8_SCHED; PG8_LDA(At, 1, 0); PG8_STAGE(PG8_SA(0, 1), a2 + hstep, voffA);
            PG8_WAIT_L(8); PG8_BAR; PG8_WAIT_L(0); PG8_MMA(0, 0, At, B0); PG8_BAR; PG8_SCHED;
            PG8_LDB(B1, 1, 1); PG8_STAGE(PG8_SB(1, 0), b3, voffB);
            PG8_BAR; PG8_WAIT_L(0); PG8_MMA(0, 1, At, B1); PG8_BAR;
            PG8_LDA(At, 1, 1); PG8_STAGE(PG8_SA(1, 0), a3, voffA);
            PG8_BAR; PG8_WAIT_L(0); PG8_MMA(1, 0, At, B0); PG8_BAR; PG8_SCHED;
            PG8_STAGE(PG8_SB(1, 1), b3 + hstep, voffB);
            PG8_WAIT_V(6); PG8_BAR; PG8_MMA(1, 1, At, B1); PG8_BAR;
            }
        }
        if constexpr (ALIGN_EPI) { if (wr == 0) PG8_BAR; }
        if constexpr (!Epi::AFTER_DRAIN) { E(acc, cur, wr, wc, fr, fq); S.done(cur); }
        if (!has_next) break;
#pragma unroll
        for (int a = 0; a < 2; ++a)
#pragma unroll
            for (int b = 0; b < 2; ++b)
#pragma unroll
                for (int m = 0; m < 4; ++m)
#pragma unroll
                    for (int n = 0; n < 2; ++n) acc[a][b][m][n] = (f32x4){0.f, 0.f, 0.f, 0.f};
        cur = nxt; cA = nA; cB = nB; ++ui;
        if constexpr (ALIGN_EPI) { if (wr == 1) PG8_BAR; }
    }
    PG8_WAIT_V(0);
    if constexpr (!ALIGN_EPI) { if (wr == 0) PG8_BAR; }
    PG8_BAR;
    if constexpr (Epi::AFTER_DRAIN) { E.fused(acc, cur, wr, wc, fr, fq, lds, wid, lane); S.done(cur); }
#undef PG8_SA
#undef PG8_SB
#undef PG8_STAGE
#undef PG8_LDA
#undef PG8_LDB
#undef PG8_MMA
#undef PG8_WAIT_V
#undef PG8_WAIT_L
#undef PG8_BAR
#undef PG8_SCHED
}
}
namespace att {
using bf16 = __hip_bfloat16;
constexpr int   D = 128, NW = 8, QBLK = 32, KVBLK = 64;
constexpr float SCALE = 0.088388347648318440f;
constexpr float THR = 8.f;
#ifndef ATT_A_SDEPTH
#define ATT_A_SDEPTH 1
#endif
constexpr int SDEPTH = 2;
constexpr int LDQ = 4608, LDK = 4608, LDO = 2048;
constexpr size_t SHM_V = KVBLK * D * 2, SHM_K = KVBLK * D * 2, SHM_ATTN = 2 * SHM_V + 2 * SHM_K + NW * 64 * 4;
using bf16x8 = __attribute__((ext_vector_type(8))) short;
using s16x4  = __attribute__((ext_vector_type(4))) short;
using f32x16 = __attribute__((ext_vector_type(16))) float;
using f32x8  = __attribute__((ext_vector_type(8))) float;
using u32x4  = __attribute__((ext_vector_type(4))) unsigned;
#define KSWZ(row, colB) ((row) * 256 + ((colB) ^ (((row) & 7) << 4)))
#define SBAR() __builtin_amdgcn_sched_barrier(0)
__device__ __forceinline__ int crow(int r, int hi) { return (r & 3) + 8 * (r >> 2) + 4 * hi; }
__device__ __forceinline__ unsigned cvtpk(float lo, float hi) {
  unsigned r; asm volatile("v_cvt_pk_bf16_f32 %0, %1, %2" : "=v"(r) : "v"(lo), "v"(hi)); return r;
}
template <typename TIn> struct Stage;
template <> struct Stage<bf16>  { using T = bf16x8;
  __device__ static __forceinline__ T ld8(const bf16* p) { return *reinterpret_cast<const bf16x8*>(p); }
  __device__ static __forceinline__ bf16x8 tobf(T x) { return x; } };
template <> struct Stage<float> { using T = f32x8;
  __device__ static __forceinline__ T ld8(const float* p) { return *reinterpret_cast<const f32x8*>(p); }
  __device__ static __forceinline__ bf16x8 tobf(T x) {
    u32x4 w = {cvtpk(x[0], x[1]), cvtpk(x[2], x[3]), cvtpk(x[4], x[5]), cvtpk(x[6], x[7])}; return *reinterpret_cast<bf16x8*>(&w); } };

__device__ __forceinline__ void partialSM(f32x16& p0, f32x16& p1, float& m_reg, float& mn, float& alpha) {
  constexpr float C = SCALE * 1.4426950408889634f;
  float pmax = p0[0]; for (int r = 1; r < 16; ++r) pmax = fmaxf(pmax, p0[r]); for (int r = 0; r < 16; ++r) pmax = fmaxf(pmax, p1[r]);
  { auto rr = __builtin_amdgcn_permlane32_swap(__float_as_uint(pmax), __float_as_uint(pmax), false, false);
    pmax = fmaxf(__uint_as_float(rr[0]), __uint_as_float(rr[1])); }
  if (__builtin_expect(__all(pmax - m_reg <= THR / SCALE), 1)) { mn = m_reg; alpha = 1.f; }
  else { mn = fmaxf(m_reg, pmax); alpha = __builtin_amdgcn_exp2f((m_reg - mn) * C); m_reg = mn; }
  float mnC = -mn * C;
  for (int r = 0; r < 16; ++r) p0[r] = fmaf(p0[r], C, mnC); for (int r = 0; r < 16; ++r) p1[r] = fmaf(p1[r], C, mnC);
  for (int r = 0; r < 16; ++r) p0[r] = __builtin_amdgcn_exp2f(p0[r]);
}
__device__ __forceinline__ void finishSM(f32x16& p0, f32x16& p1, float alpha, float& l_reg, bf16x8& pa0, bf16x8& pa1, bf16x8& pa2, bf16x8& pa3) {
  for (int r = 0; r < 16; ++r) p1[r] = __builtin_amdgcn_exp2f(p1[r]);
  float ps = 0; for (int r = 0; r < 16; ++r) ps += p0[r]; for (int r = 0; r < 16; ++r) ps += p1[r];
  { auto rr = __builtin_amdgcn_permlane32_swap(__float_as_uint(ps), __float_as_uint(ps), false, false);
    ps = __uint_as_float(rr[0]) + __uint_as_float(rr[1]); }
  l_reg = l_reg * alpha + ps;
#define PK4(P, BASE, OUT) do { unsigned a0 = cvtpk(P[BASE + 0], P[BASE + 1]), a1 = cvtpk(P[BASE + 2], P[BASE + 3]);   \
    unsigned b0 = cvtpk(P[BASE + 4], P[BASE + 5]), b1 = cvtpk(P[BASE + 6], P[BASE + 7]);                              \
    auto r0 = __builtin_amdgcn_permlane32_swap(a0, b0, false, false); auto r1 = __builtin_amdgcn_permlane32_swap(a1, b1, false, false); \
    u32x4 w = {r0[0], r1[0], r0[1], r1[1]}; OUT = *reinterpret_cast<bf16x8*>(&w); } while (0)
  PK4(p0, 0, pa0); PK4(p0, 8, pa1); PK4(p1, 0, pa2); PK4(p1, 8, pa3);
#undef PK4
}
__device__ __forceinline__ void qkt(f32x16& p0, f32x16& p1, const bf16* Ks, const bf16x8* qr, int r32, int hi) {
  p0 = f32x16{}; p1 = f32x16{};
  for (int d0 = 0; d0 < 8; ++d0) { int cb = (d0 * 16 + hi * 8) * 2;
    bf16x8 b0 = *reinterpret_cast<const bf16x8*>((const char*)Ks + KSWZ(r32, cb));
    bf16x8 b1 = *reinterpret_cast<const bf16x8*>((const char*)Ks + KSWZ(32 + r32, cb));
    p0 = __builtin_amdgcn_mfma_f32_32x32x16_bf16(b0, qr[d0], p0, 0, 0, 0);
    p1 = __builtin_amdgcn_mfma_f32_32x32x16_bf16(b1, qr[d0], p1, 0, 0, 0); }
}
__device__ __forceinline__ int v_st(int k, int c) { const int kk = (k & ~0xC) | ((k & 4) << 1) | ((k & 8) >> 1); return ((kk >> 3) * 4 + (c >> 5)) * 512 + ((kk & 7) * 32 + (c & 31)) * 2; }
__device__ __forceinline__ int v_rd_base(int lane) { return ((lane & 3) << 3) | (((lane >> 2) & 3) << 6) | (((lane >> 4) & 1) << 5) | (((lane >> 5) & 1) << 8); }
constexpr int v_rd_off(int d0, int ks, int half) { return d0 * 512 + ks * 4096 + half * 2048; }
template <int OFF> __device__ __forceinline__ s16x4 tr_read(int vb) {
  s16x4 r; asm volatile("ds_read_b64_tr_b16 %0, %1 offset:%2" : "=&v"(r) : "v"(vb), "i"(OFF) : "memory"); return r;
}
template <int D0> __device__ __forceinline__ void pv_one(f32x16& od, int vb, bf16x8 pa0, bf16x8 pa1, bf16x8 pa2, bf16x8 pa3) {
  const s16x4 l0 = tr_read<v_rd_off(D0, 0, 0)>(vb), h0 = tr_read<v_rd_off(D0, 0, 1)>(vb), l1 = tr_read<v_rd_off(D0, 1, 0)>(vb), h1 = tr_read<v_rd_off(D0, 1, 1)>(vb);
  const s16x4 l2 = tr_read<v_rd_off(D0, 2, 0)>(vb), h2 = tr_read<v_rd_off(D0, 2, 1)>(vb), l3 = tr_read<v_rd_off(D0, 3, 0)>(vb), h3 = tr_read<v_rd_off(D0, 3, 1)>(vb);
  asm volatile("s_waitcnt lgkmcnt(0)" ::: "memory"); SBAR();
#define PK(L, H) (bf16x8){L[0], L[1], L[2], L[3], H[0], H[1], H[2], H[3]}
  od = __builtin_amdgcn_mfma_f32_32x32x16_bf16(pa0, PK(l0, h0), od, 0, 0, 0);
  od = __builtin_amdgcn_mfma_f32_32x32x16_bf16(pa1, PK(l1, h1), od, 0, 0, 0);
  od = __builtin_amdgcn_mfma_f32_32x32x16_bf16(pa2, PK(l2, h2), od, 0, 0, 0);
  od = __builtin_amdgcn_mfma_f32_32x32x16_bf16(pa3, PK(l3, h3), od, 0, 0, 0);
#undef PK
}
__device__ __forceinline__ void pv_d0(f32x16* o, int vb, bf16x8 pa0, bf16x8 pa1, bf16x8 pa2, bf16x8 pa3) {
  pv_one<0>(o[0], vb, pa0, pa1, pa2, pa3); pv_one<1>(o[1], vb, pa0, pa1, pa2, pa3); pv_one<2>(o[2], vb, pa0, pa1, pa2, pa3); pv_one<3>(o[3], vb, pa0, pa1, pa2, pa3);
}


typedef const __attribute__((address_space(3))) float* lds_cf;
__device__ __forceinline__ void nbmask(f32x16& p0, f32x16& p1, int kr, int rq, int cq, int hi, lds_cf tbl) {
  int r0 = rq - 4; r0 = r0 < 0 ? 0 : (r0 > 248 ? 248 : r0);
  int c0 = cq - 8; c0 = c0 < 0 ? 0 : (c0 > 48 ? 48 : c0);
  const bool row_ok = (unsigned)(kr - r0) < 8u;
  const unsigned long long cm = row_ok ? ((0xFFFFull << c0) >> (4 * hi)) : 0ull;
  const unsigned mlo = (unsigned)cm, mhi = (unsigned)(cm >> 32);
  const int dr = row_ok ? kr - rq + 7 : 0;
  lds_cf tb = tbl + (dr * 128 + 63 - cq + 4 * hi);
#pragma unroll
  for (int r = 0; r < 16; ++r) {
    const int bit = (r & 3) + 8 * (r >> 2);
    float b0 = tb[bit], b1 = tb[bit + 32]; asm volatile("" : "+v"(b0), "+v"(b1));
    p0[r] = (mlo & (1u << bit)) ? p0[r] + b0 : -INFINITY; p1[r] = (mhi & (1u << bit)) ? p1[r] + b1 : -INFINITY;
  }
}
template <bool NB>
__device__ __forceinline__ void attn_dense_body(const bf16* __restrict__ Qb, const bf16* __restrict__ Kh, const bf16* __restrict__ Vh,
                                                bf16* __restrict__ Ob, int seq, char* lds, int tq0, int krow0, int wave_s) {
  using TQ = bf16; constexpr int SDEPTH = NB ? 1 : ATT_A_SDEPTH;
  using St = Stage<bf16>; using SQ = Stage<TQ>;
  int tid_ = __builtin_amdgcn_mbcnt_hi(~0u, __builtin_amdgcn_mbcnt_lo(~0u, 0u)); asm volatile("" : "+v"(tid_)); tid_ += wave_s * 64;
  const int tid = tid_, wid = tid >> 6, lane = tid & 63, r32 = lane & 31, hi = lane >> 5;
  bf16* V_lds = (bf16*)lds; bf16* K_lds = (bf16*)(lds + 2 * SHM_V);
  float* ws = (float*)(lds + 2 * SHM_V + 2 * SHM_K) + wid * 64; float* li_l = ws; float* al_l = ws + 32;
  float m_reg = -1e30f, l_reg = 0; f32x16 o[4] = {}; bf16x8 qr[8];
  lds_cf tbl = (lds_cf)(__attribute__((address_space(3))) char*)(lds + SHM_ATTN);
  const int nb_tq = tq0 + wid * QBLK + r32, nb_rq = nb_tq >> 6, nb_cq = nb_tq & 63;
  const TQ* Qw = Qb + (long)(wid * QBLK + r32) * LDQ + hi * 8;
#pragma unroll
  for (int d0 = 0; d0 < 8; ++d0) qr[d0] = SQ::tobf(SQ::ld8(Qw + d0 * 16));
  const int sr = tid >> 4, sc = (tid & 15) * 8, vst0 = v_st(sr, sc), vst1 = v_st(32 + sr, sc);
  const int vb0 = (int)(uintptr_t)V_lds + v_rd_base(lane);
  struct { typename St::T vs0, vs1, ks0, ks1; } sr_[SDEPTH];
#define SLOAD(i, k0) do { sr_[i].vs0 = St::ld8(&Vh[(long)((k0) + sr) * LDK + sc]); sr_[i].vs1 = St::ld8(&Vh[(long)((k0) + 32 + sr) * LDK + sc]); \
    sr_[i].ks0 = St::ld8(&Kh[(long)((k0) + sr) * LDK + sc]); sr_[i].ks1 = St::ld8(&Kh[(long)((k0) + 32 + sr) * LDK + sc]); } while (0)
#define SWRITE(b, i) do { *(bf16x8*)((char*)V_lds + (b) * SHM_V + vst0) = St::tobf(sr_[i].vs0);          \
    *(bf16x8*)((char*)V_lds + (b) * SHM_V + vst1) = St::tobf(sr_[i].vs1); int kc = sc * 2;               \
    *(bf16x8*)((char*)K_lds + (b) * SHM_K + KSWZ(sr, kc)) = St::tobf(sr_[i].ks0);                       \
    *(bf16x8*)((char*)K_lds + (b) * SHM_K + KSWZ(32 + sr, kc)) = St::tobf(sr_[i].ks1); } while (0)
#define SWAIT() do { if constexpr (SDEPTH == 2) asm volatile("s_waitcnt vmcnt(4)" ::: "memory"); else asm volatile("s_waitcnt vmcnt(0)" ::: "memory"); } while (0)
#define RESC(a) do { if (__any((a) < 1.f)) { if (hi == 0) al_l[r32] = (a); asm volatile("s_waitcnt lgkmcnt(0)" ::: "memory"); \
    for (int d = 0; d < 4; ++d) for (int r = 0; r < 16; ++r) o[d][r] *= al_l[crow(r, hi)]; } } while (0)
  f32x16 pA0, pA1, pB0, pB1; float mnA, mnB, alA, alB; bf16x8 pa0, pa1, pa2, pa3; const int NT = seq / KVBLK;
  constexpr int SE = 0, SO = SDEPTH - 1;
  SLOAD(SE, 0); asm volatile("s_waitcnt vmcnt(0)" ::: "memory"); SWRITE(0, SE); __syncthreads();
  qkt(pA0, pA1, K_lds, qr, r32, hi); if constexpr (NB) nbmask(pA0, pA1, krow0, nb_rq, nb_cq, hi, tbl); partialSM(pA0, pA1, m_reg, mnA, alA);
  SLOAD(SO, KVBLK); if constexpr (SDEPTH == 2) { if (2 < NT) SLOAD(SE, 2 * KVBLK); }
  SWAIT(); SWRITE(1, SO); __syncthreads();
  for (int j = 1; j + 1 < NT; j += 2) {
    SBAR(); qkt(pB0, pB1, (bf16*)((char*)K_lds + SHM_K), qr, r32, hi); if constexpr (NB) nbmask(pB0, pB1, krow0 + j, nb_rq, nb_cq, hi, tbl);
    finishSM(pA0, pA1, alA, l_reg, pa0, pa1, pa2, pa3); SBAR();
    SLOAD(SO, (j + SDEPTH) * KVBLK); SBAR();
    pv_d0(o, vb0, pa0, pa1, pa2, pa3); partialSM(pB0, pB1, m_reg, mnB, alB);
    __syncthreads(); SWAIT(); SWRITE(0, SE);
    RESC(alB); __syncthreads();
    SBAR(); qkt(pA0, pA1, K_lds, qr, r32, hi); if constexpr (NB) nbmask(pA0, pA1, krow0 + j + 1, nb_rq, nb_cq, hi, tbl);
    finishSM(pB0, pB1, alB, l_reg, pa0, pa1, pa2, pa3); SBAR();
    if (SDEPTH == 1 || j + 3 < NT) SLOAD(SE, (j + 1 + SDEPTH) * KVBLK); SBAR();
    pv_d0(o, vb0 + (int)SHM_V, pa0, pa1, pa2, pa3); partialSM(pA0, pA1, m_reg, mnA, alA);
    __syncthreads(); SWAIT(); SWRITE(1, SO);
    RESC(alA); __syncthreads();
  }
  SBAR(); qkt(pB0, pB1, (bf16*)((char*)K_lds + SHM_K), qr, r32, hi); if constexpr (NB) nbmask(pB0, pB1, krow0 + NT - 1, nb_rq, nb_cq, hi, tbl);
  finishSM(pA0, pA1, alA, l_reg, pa0, pa1, pa2, pa3); SBAR();
  pv_d0(o, vb0, pa0, pa1, pa2, pa3); partialSM(pB0, pB1, m_reg, mnB, alB);
  __syncthreads(); RESC(alB);
  finishSM(pB0, pB1, alB, l_reg, pa0, pa1, pa2, pa3); SBAR();
  pv_d0(o, vb0 + (int)SHM_V, pa0, pa1, pa2, pa3);
  if (hi == 0) li_l[r32] = l_reg; asm volatile("s_waitcnt lgkmcnt(0)" ::: "memory");
  float rli[16];
#pragma unroll
  for (int r = 0; r < 16; ++r) rli[r] = __builtin_amdgcn_rcpf(li_l[crow(r, hi)]);
  bf16* Ow = Ob + (long)(wid * QBLK) * LDO;
#pragma unroll
  for (int r = 0; r < 16; ++r) { int orow = crow(r, hi);
    for (int d0 = 0; d0 < 4; ++d0) Ow[(long)orow * LDO + d0 * 32 + r32] = __float2bfloat16(o[d0][r] * rli[r]); }
  __syncthreads();
#undef SLOAD
#undef SWRITE
#undef SWAIT
#undef RESC
}

#undef KSWZ
}
#ifndef MK_N_LAUNCHES
#define MK_N_LAUNCHES 1
#endif
constexpr int NWAVES = 8, NTHR = NWAVES * 64;
constexpr int S = 16384, DM = 2048, INW = 4608, DFF = 8192, PLE = 256, NPH = 11;
constexpr float EPS = 1e-6f;
typedef unsigned short bf16r;
typedef float f32x4 __attribute__((ext_vector_type(4)));
typedef unsigned v4u __attribute__((ext_vector_type(4)));
typedef unsigned v2u __attribute__((ext_vector_type(2)));
#define LAS __attribute__((address_space(3)))
#define GAS __attribute__((address_space(1)))
constexpr size_t MiB = 1u << 20;
constexpr size_t WS_WIN = 1 * MiB, WS_WO = 19 * MiB, WS_WUP = 27 * MiB, WS_WDN = 59 * MiB, WS_WG = 91 * MiB, WS_WP = 99 * MiB;
constexpr size_t WS_PBF = 100 * MiB;
constexpr size_t WS_A = 108 * MiB;
constexpr size_t WS_B = 364 * MiB;
constexpr size_t WS_END = 492 * MiB;
constexpr int LDS_BYTES = 147456; constexpr int MISC_OFF = 131072 + 320;
constexpr size_t WS_CTL = 0, CTL_ZERO_BYTES = 16384;

__device__ __forceinline__ unsigned f2bf(float f) { unsigned u = __builtin_bit_cast(unsigned, f); return (u + 0x7fffu + ((u >> 16) & 1u)) >> 16; }
__device__ __forceinline__ unsigned pk2(float lo, float hi) { return f2bf(lo) | (f2bf(hi) << 16); }
__device__ __forceinline__ float bf2f(unsigned short b) { return __builtin_bit_cast(float, (unsigned)b << 16); }
__device__ __forceinline__ float wave_sum(float v) {
#pragma unroll
    for (int o = 1; o < 64; o <<= 1) v += __shfl_xor(v, o);
    return v;
}
__device__ __forceinline__ void p0_transpose_item(const float* __restrict__ W, int K, int N, bf16r* __restrict__ WT, LAS float* scr, int item, int lane) {
    const int nblk = N / 32, kb = item / nblk, nb = item % nblk, k0 = 64 * kb, n0 = 32 * nb;
#pragma unroll 8
    for (int i = 0; i < 32; ++i) { const int kk = 2 * i + (lane >> 5); scr[kk * 33 + (lane & 31)] = W[(size_t)(k0 + kk) * N + n0 + (lane & 31)]; }
    asm volatile("s_waitcnt lgkmcnt(0)" ::: "memory");
    const int c = lane & 7;
#pragma unroll
    for (int j = 0; j < 4; ++j) { const int n = (lane >> 3) + 8 * j; const LAS float* s = scr + (8 * c) * 33 + n;
        v4u o; o.x = pk2(s[0 * 33], s[1 * 33]); o.y = pk2(s[2 * 33], s[3 * 33]); o.z = pk2(s[4 * 33], s[5 * 33]); o.w = pk2(s[6 * 33], s[7 * 33]);
        *(v4u*)(WT + (size_t)(n0 + n) * K + k0 + 8 * c) = o; }
    asm volatile("s_waitcnt lgkmcnt(0)" ::: "memory");
}
__device__ __forceinline__ void row_norm_bf16(const float* __restrict__ xrow, const float* __restrict__ g, bf16r* __restrict__ orow, int lane) {
    const f32x4* xr = (const f32x4*)xrow + lane; const f32x4* gr = (const f32x4*)g + lane;
    f32x4 v[8]; float s = 0.f;
#pragma unroll
    for (int j = 0; j < 8; ++j) { v[j] = xr[64 * j]; s += (v[j].x * v[j].x + v[j].y * v[j].y) + (v[j].z * v[j].z + v[j].w * v[j].w); }
    const float rs = rsqrtf(wave_sum(s) * (1.f / DM) + EPS);
    v2u* o8 = (v2u*)orow + lane;
#pragma unroll
    for (int j = 0; j < 8; ++j) { const f32x4 gj = gr[64 * j]; v2u w; w.x = pk2(v[j].x * rs * gj.x, v[j].y * rs * gj.y); w.y = pk2(v[j].z * rs * gj.z, v[j].w * rs * gj.w); o8[64 * j] = w; }
}
template <bool XN>
__device__ __forceinline__ void row_res_norm(const float* res, const float* __restrict__ trow, const float* __restrict__ gpost, const float* __restrict__ gpre,
                                             float* hout, bf16r* __restrict__ xnout, int lane) {
    const f32x4* tr = (const f32x4*)trow + lane; const f32x4* rr = (const f32x4*)res + lane; const f32x4* gp = (const f32x4*)gpost + lane;
    f32x4 t[8], h[8]; float s = 0.f;
#pragma unroll
    for (int j = 0; j < 8; ++j) { t[j] = tr[64 * j]; h[j] = rr[64 * j]; s += (t[j].x * t[j].x + t[j].y * t[j].y) + (t[j].z * t[j].z + t[j].w * t[j].w); }
    const float rs = rsqrtf(wave_sum(s) * (1.f / DM) + EPS);
    float s2 = 0.f; f32x4* ho = (f32x4*)hout + lane;
#pragma unroll
    for (int j = 0; j < 8; ++j) { const f32x4 gj = gp[64 * j]; h[j] = h[j] + t[j] * rs * gj; ho[64 * j] = h[j];
        s2 += (h[j].x * h[j].x + h[j].y * h[j].y) + (h[j].z * h[j].z + h[j].w * h[j].w); }
    if constexpr (XN) {
        const float rs2 = rsqrtf(wave_sum(s2) * (1.f / DM) + EPS);
        const f32x4* gq = (const f32x4*)gpre + lane; v2u* o8 = (v2u*)xnout + lane;
#pragma unroll
        for (int j = 0; j < 8; ++j) { const f32x4 gj = gq[64 * j]; v2u w; w.x = pk2(h[j].x * rs2 * gj.x, h[j].y * rs2 * gj.y); w.y = pk2(h[j].z * rs2 * gj.z, h[j].w * rs2 * gj.w); o8[64 * j] = w; }
    }
}

#define XB_TMO      128
#define XB_XCNT(j)  (256  + 64 * (j))
#define XB_XSUB(j)  (1280 + 64 * (j))
#define XB_XGEN(j)  (2304 + 64 * (j))
#define XB_TOP      3328
#define XB_TOPGEN   3392
#define XCD_BAR_WORDS 3456
#define XB_SPIN_CAP (1u << 18)

__device__ __forceinline__ unsigned xb_ld(unsigned* p)              { return __hip_atomic_load(p, __ATOMIC_RELAXED, __HIP_MEMORY_SCOPE_AGENT); }
__device__ __forceinline__ unsigned xb_add(unsigned* p, unsigned v) { return __hip_atomic_fetch_add(p, v, __ATOMIC_RELAXED, __HIP_MEMORY_SCOPE_AGENT); }
__device__ __forceinline__ unsigned xb_xcc_id() { return (unsigned)__builtin_amdgcn_s_getreg((3 << 11) | 20) & 0xFu; }
#define XB_SPIN(cond, bar) do { unsigned _sp = 0; while (cond) { __builtin_amdgcn_s_sleep(1); \
    if ((++_sp & 255u) == 0u) { if (xb_ld(&(bar)[XB_TMO])) break; if (_sp > XB_SPIN_CAP) { atomicAdd(&(bar)[XB_TMO], 1u); break; } } } } while (0)

struct XcdBarrier {
    bool t0;
    unsigned* bar; unsigned x;
    volatile LAS unsigned* st;
};

__device__ __forceinline__ XcdBarrier xcd_barrier_post(unsigned* bar, volatile LAS unsigned* st) {
    XcdBarrier b; b.t0 = threadIdx.x == 0; b.bar = bar; b.x = xb_xcc_id(); b.st = st;
    if (threadIdx.x == 0) (void)xb_add(&bar[XB_XCNT(b.x)], 1u);
    return b;
}
__device__ __forceinline__ void xcd_barrier_complete(unsigned* bar, unsigned x, unsigned& nloc, unsigned& nx) {
    const unsigned G = gridDim.x * gridDim.y * gridDim.z;
    unsigned sum, cnt, mine, sp = 0u;
    for (;;) {
        sum = 0u; cnt = 0u; mine = 0u;
#pragma unroll
        for (unsigned j = 0; j < 16; ++j) { const unsigned c = xb_ld(&bar[XB_XCNT(j)]); sum += c; cnt += (c > 0u) ? 1u : 0u; mine = (j == x) ? c : mine; }
        if (sum == G) break;
        __builtin_amdgcn_s_sleep(1);
        if ((++sp & 255u) == 0u) { if (xb_ld(&bar[XB_TMO])) break; if (sp > XB_SPIN_CAP) { atomicAdd(&bar[XB_TMO], 1u); break; } }
    }
    nloc = mine > 0u ? mine : 1u; nx = cnt > 0u ? cnt : 1u;
}

__device__ __forceinline__ void xcd_barrier(const XcdBarrier& b) {
    asm volatile("s_waitcnt vmcnt(0)" ::: "memory");
    __syncthreads();
    if (b.t0) {
        unsigned* bar = b.bar;
        __builtin_amdgcn_s_waitcnt(0);
        unsigned nloc = b.st[0], nx = b.st[1];
        if (nloc == 0u) { xcd_barrier_complete(bar, b.x, nloc, nx); b.st[0] = nloc; b.st[1] = nx; }
        const unsigned old = xb_add(&bar[XB_XSUB(b.x)], 1u);
        const unsigned gen = old / nloc;
        if (old + 1u == (gen + 1u) * nloc) {
            __builtin_amdgcn_fence(__ATOMIC_RELEASE, "agent");
            asm volatile("s_waitcnt vmcnt(0)" ::: "memory");
            const unsigned og = xb_add(&bar[XB_TOP], 1u);
            const unsigned tg = og / nx;
            if (og + 1u == (tg + 1u) * nx) xb_add(&bar[XB_TOPGEN], 1u);
            else XB_SPIN(xb_ld(&bar[XB_TOPGEN]) == tg, bar);
            __builtin_amdgcn_fence(__ATOMIC_ACQUIRE, "agent");
            xb_add(&bar[XB_XGEN(b.x)], 1u);
            asm volatile("s_waitcnt vmcnt(0)" ::: "memory");
        } else {
            XB_SPIN(xb_ld(&bar[XB_XGEN(b.x)]) == gen, bar);
            __builtin_amdgcn_fence(__ATOMIC_ACQUIRE, "agent");
            asm volatile("s_waitcnt vmcnt(0)" ::: "memory");
        }
    }
    __syncthreads();
}
#define A_X        (args.in[0])
#define A_P        (args.in[1])
#define A_GPREMIX  (args.in[2])
#define A_WIN      (args.in[3])
#define A_GQ       (args.in[4])
#define A_GK       (args.in[5])
#define A_RPB      (args.in[6])
#define A_WO       (args.in[7])
#define A_GPOSTMIX (args.in[8])
#define A_GPREMLP  (args.in[9])
#define A_WUP      (args.in[10])
#define A_WDN      (args.in[11])
#define A_GPOSTMLP (args.in[12])
#define A_GPREPLE  (args.in[13])
#define A_WGATE    (args.in[14])
#define A_WPLE     (args.in[15])
#define A_GPOSTPLE (args.in[16])
#define W_(off)    (args.ws + (off))
struct Args { const float* in[17]; float* out; unsigned char* ws; int ph_lo, ph_hi; };

__global__ void __launch_bounds__(NTHR, 2) mega_fwd(Args args) {
    extern __shared__ __attribute__((aligned(16))) unsigned char lds[];
    const int G = gridDim.x, bx = blockIdx.x, NGW = G * NWAVES;
    const int wave_s = __builtin_amdgcn_readfirstlane((int)threadIdx.x >> 6);
#define LANEVARS int lane_ = __builtin_amdgcn_mbcnt_hi(~0u, __builtin_amdgcn_mbcnt_lo(~0u, 0u)); asm volatile("" : "+v"(lane_)); const int lane = lane_, wave = wave_s, tid = wave * 64 + lane, gw = bx * NWAVES + wave; (void)lane; (void)gw; (void)tid;
    const int lo = args.ph_lo, hi = args.ph_hi;
#ifdef ONLY_PHASE
#define IN(k) ((k) == ONLY_PHASE && lo <= (k) && (k) < hi)
#else
#define IN(k) (lo <= (k) && (k) < hi)
#endif
#define SEAM(k) do { if (IN(k) && IN((k) + 1)) { if ((k) == 0) cg::this_grid().sync(); else { XcdBarrier xb_; xb_.t0 = (wave_s == 0) && (__builtin_amdgcn_mbcnt_hi(~0u, __builtin_amdgcn_mbcnt_lo(~0u, 0u)) == 0); xb_.bar = (unsigned*)args.ws; xb_.x = xb_xcc_id(); xb_.st = (volatile LAS unsigned*)((LAS unsigned char*)lds + MISC_OFF) + 8; xcd_barrier(xb_); } } } while (0)
    LAS unsigned char* ldsl = (LAS unsigned char*)lds;
    if (hi - lo > 1) {
        for (int u = threadIdx.x; u < (LDS_BYTES - 131072) / 4; u += NTHR) ((LAS unsigned*)(ldsl + 131072))[u] = 0u;
        __syncthreads();
        (void)xcd_barrier_post((unsigned*)args.ws, (volatile LAS unsigned*)(ldsl + MISC_OFF) + 8);
    }

    if (IN(0)) {
        LANEVARS
        LAS float* scr = (LAS float*)(ldsl + wave * 16384);
        constexpr int I_IN = (DM / 64) * (INW / 32), I_O = (DM / 64) * (DM / 32), I_UP = (DM / 64) * (DFF / 32), I_DN = (DFF / 64) * (DM / 32), I_G = I_O, I_P = (PLE / 64) * (DM / 32);
        constexpr int NITEMS = I_IN + I_O + I_UP + I_DN + I_G + I_P;
        for (int it = gw; it < NITEMS; it += NGW) {
            int r = it;
            if (r < I_IN) { p0_transpose_item(A_WIN, DM, INW, (bf16r*)W_(WS_WIN), scr, r, lane); continue; } r -= I_IN;
            if (r < I_O) { p0_transpose_item(A_WO, DM, DM, (bf16r*)W_(WS_WO), scr, r, lane); continue; } r -= I_O;
            if (r < I_UP) { p0_transpose_item(A_WUP, DM, DFF, (bf16r*)W_(WS_WUP), scr, r, lane); continue; } r -= I_UP;
            if (r < I_DN) { p0_transpose_item(A_WDN, DFF, DM, (bf16r*)W_(WS_WDN), scr, r, lane); continue; } r -= I_DN;
            if (r < I_G) { p0_transpose_item(A_WGATE, DM, DM, (bf16r*)W_(WS_WG), scr, r, lane); continue; } r -= I_G;
            p0_transpose_item(A_WPLE, PLE, DM, (bf16r*)W_(WS_WP), scr, r, lane);
        }
        for (int m = gw; m < S; m += NGW) row_norm_bf16(A_X + (size_t)m * DM, A_GPREMIX, (bf16r*)W_(WS_B) + (size_t)m * DM, lane);
        for (size_t i = (size_t)bx * NTHR + tid; i < (size_t)S * PLE / 8; i += (size_t)G * NTHR) {
            const f32x4 a = ((const f32x4*)A_P)[2 * i], b = ((const f32x4*)A_P)[2 * i + 1];
            v4u o; o.x = pk2(a.x, a.y); o.y = pk2(a.z, a.w); o.z = pk2(b.x, b.y); o.w = pk2(b.z, b.w); ((v4u*)W_(WS_PBF))[i] = o; }
        __syncthreads();
    }
    SEAM(0);
    if (IN(1)) {
        pg8::Gemm g{(const bf16r*)W_(WS_B), (const bf16r*)W_(WS_WIN), S, INW, DM}; pg8::StaticOrder So; So.init(S, INW, G, bx);
        pg8::EpiBf16<0> E{(bf16r*)W_(WS_A), INW};
        pg8::gemm_phase<pg8::EpiBf16<0>, pg8::StaticOrder, true, true>(ldsl, g, So, E, wave_s);
    }
    SEAM(1);
    if (IN(2)) {
        LANEVARS
        const int sh = lane >> 4, k = lane & 15, half = k >> 3, kk = k & 7; const bool is_x1 = kk < 4;
        float freq[8], gq[8], gk[8];
#pragma unroll
        for (int e = 0; e < 8; ++e) { freq[e] = exp2f(-(float)(8 * (kk & 3) + e) * (13.287712379549449f / 32.f)); gq[e] = A_GQ[8 * k + e]; gk[e] = A_GK[8 * k + e]; }
        bf16r* PROJ = (bf16r*)W_(WS_A);
        int it = gw; v4u raw = {0u, 0u, 0u, 0u};
        { const int t = it / 3, hd = (it - t * 3) * 4 + sh; if (it < S * 3 && hd < 10) raw = *(const v4u*)(PROJ + (size_t)t * INW + hd * 128 + 8 * k); }
        for (; it < S * 3; it += NGW) {
            const int t = it / 3, hd = (it - t * 3) * 4 + sh; const v4u cur = raw;
            { const int it2 = it + NGW, t2 = it2 / 3, hd2 = (it2 - t2 * 3) * 4 + sh; if (it2 < S * 3 && hd2 < 10) raw = *(const v4u*)(PROJ + (size_t)t2 * INW + hd2 * 128 + 8 * k); }
            float xv[8]; float ss = 0.f;
#pragma unroll
            for (int e = 0; e < 4; ++e) { xv[2 * e] = __builtin_bit_cast(float, cur[e] << 16); xv[2 * e + 1] = __builtin_bit_cast(float, cur[e] & 0xffff0000u); }
#pragma unroll
            for (int e = 0; e < 8; ++e) ss += xv[e] * xv[e];
            ss += __shfl_xor(ss, 1); ss += __shfl_xor(ss, 2); ss += __shfl_xor(ss, 4); ss += __shfl_xor(ss, 8);
            const float rs = rsqrtf(ss * (1.f / 128.f) + EPS);
            const float posf = (float)(half ? (t & 63) : (t >> 6));
            float o[8];
#pragma unroll
            for (int e = 0; e < 8; ++e) {
                const float y = xv[e] * rs * (hd < 8 ? gq[e] : gk[e]); const float py = __shfl_xor(y, 4);
                const float ang = posf * freq[e];
                double rev = (double)ang * 0.15915494309189535; rev -= floor(rev);
                const float fr = (float)rev; const float sn = __builtin_amdgcn_sinf(fr), cs = __builtin_amdgcn_cosf(fr);
                o[e] = is_x1 ? y * cs - py * sn : y * cs + py * sn;
            }
            if (hd < 10) { v4u w; w.x = pk2(o[0], o[1]); w.y = pk2(o[2], o[3]); w.z = pk2(o[4], o[5]); w.w = pk2(o[6], o[7]); *(v4u*)(PROJ + (size_t)t * INW + hd * 128 + 8 * k) = w; }
        }
    }
    SEAM(2);
    if (IN(3)) {
        char* al = (char*)lds; const bf16r* PROJ = (const bf16r*)W_(WS_A); bf16r* ATT = (bf16r*)W_(WS_A + 144 * MiB); const float* rpb = A_RPB;
#ifndef ATT_NO_A
        for (int u = bx; u < 512; u += G) {
            const int h = u >> 6, qb = u & 63, kvh = h >> 2;
            const att::bf16* Q = (const att::bf16*)PROJ + (size_t)(qb * 256) * INW + h * 128;
            const att::bf16* K = (const att::bf16*)PROJ + 1024 + kvh * 128; const att::bf16* V = (const att::bf16*)PROJ + 1280 + kvh * 128;
            att::attn_dense_body<false>(Q, K, V, (att::bf16*)ATT + (size_t)(qb * 256) * DM + h * 128, S, al, 0, 0, wave_s);
        }
#endif
#ifndef ATT_NO_B
        for (int u = bx; u < 512; u += G) {
            const int h = u >> 6, qb = u & 63, R = qb * 4, rs = R - 4 < 0 ? 0 : R - 4, re = R + 8 > 256 ? 256 : R + 8;
            LAS float* tbl = (LAS float*)(ldsl + att::SHM_ATTN);
            int l2_ = __builtin_amdgcn_mbcnt_hi(~0u, __builtin_amdgcn_mbcnt_lo(~0u, 0u)); asm volatile("" : "+v"(l2_));
            for (int i = wave_s * 64 + l2_; i < 15 * 128; i += NTHR) { const int dr = i >> 7, dc = (i & 127) - 48; tbl[i] = (dc >= 0 && dc < 31) ? rpb[h * 465 + dr * 31 + dc] * (1.f / att::SCALE) : 0.f; }
            __syncthreads();
            const att::bf16* Q = (const att::bf16*)PROJ + (size_t)(qb * 256) * INW + 1536 + h * 128;
            const att::bf16* K = (const att::bf16*)PROJ + (size_t)(rs * 64) * INW + 2560 + h * 128; const att::bf16* V = K + 1024;
            att::attn_dense_body<true>(Q, K, V, (att::bf16*)ATT + (size_t)(qb * 256) * DM + 1024 + h * 128, (re - rs) * 64, al, qb * 256, rs, wave_s);
        }
#endif
    }
    SEAM(3);
    if (IN(4)) {
        pg8::Gemm g{(const bf16r*)W_(WS_A + 144 * MiB), (const bf16r*)W_(WS_WO), S, DM, DM}; pg8::StaticOrder So; So.init(S, DM, G, bx);
        pg8::EpiF32<0> E{(float*)W_(WS_A), DM};
        pg8::gemm_phase<pg8::EpiF32<0>, pg8::StaticOrder, true, true>(ldsl, g, So, E, wave_s);
    }
    SEAM(4);
    if (IN(5)) {
        LANEVARS
        for (int m = gw; m < S; m += NGW) row_res_norm<true>(A_X + (size_t)m * DM, (const float*)W_(WS_A) + (size_t)m * DM, A_GPOSTMIX, A_GPREMLP, args.out + (size_t)m * DM, (bf16r*)W_(WS_B) + (size_t)m * DM, lane);
    }
    SEAM(5);
    if (IN(6)) {
        pg8::Gemm g{(const bf16r*)W_(WS_B), (const bf16r*)W_(WS_WUP), S, DFF, DM}; pg8::StaticOrder So; So.init(S, DFF, G, bx);
        pg8::EpiBf16<2> E{(bf16r*)W_(WS_A), DFF};
        pg8::gemm_phase<pg8::EpiBf16<2>, pg8::StaticOrder, true, true>(ldsl, g, So, E, wave_s);
    }
    SEAM(6);
    if (IN(7)) {
        pg8::Gemm g{(const bf16r*)W_(WS_A), (const bf16r*)W_(WS_WDN), S, DM, DFF}; pg8::StaticOrder So; So.init(S, DM, G, bx);
        pg8::EpiF32<0> E{(float*)W_(WS_B), DM};
        pg8::gemm_phase<pg8::EpiF32<0>, pg8::StaticOrder, true, true>(ldsl, g, So, E, wave_s);
    }
    SEAM(7);
    if (IN(8)) {
        LANEVARS
        for (int m = gw; m < S; m += NGW) row_res_norm<true>(args.out + (size_t)m * DM, (const float*)W_(WS_B) + (size_t)m * DM, A_GPOSTMLP, A_GPREPLE, args.out + (size_t)m * DM, (bf16r*)W_(WS_A) + (size_t)m * DM, lane);
        __syncthreads();
        pg8::Gemm g{(const bf16r*)W_(WS_PBF), (const bf16r*)W_(WS_WP), S, DM, PLE}; pg8::StaticOrder So; So.init(S, DM, G, bx);
        pg8::EpiF32<0> E{(float*)W_(WS_A + 64 * MiB), DM};
        pg8::gemm_phase<pg8::EpiF32<0>, pg8::StaticOrder, true, true>(ldsl, g, So, E, wave_s);
    }
    SEAM(8);
    if (IN(9)) {
        pg8::Gemm g{(const bf16r*)W_(WS_A), (const bf16r*)W_(WS_WG), S, DM, DM}; pg8::StaticOrder So; So.init(S, DM, G, bx);
        pg8::EpiF32<1> E{(float*)W_(WS_A + 64 * MiB), DM};
        pg8::gemm_phase<pg8::EpiF32<1>, pg8::StaticOrder, true, true>(ldsl, g, So, E, wave_s);
    }
    SEAM(9);
    if (IN(10)) {
        LANEVARS
        for (int m = gw; m < S; m += NGW) row_res_norm<false>(args.out + (size_t)m * DM, (const float*)W_(WS_A + 64 * MiB) + (size_t)m * DM, A_GPOSTPLE, nullptr, args.out + (size_t)m * DM, nullptr, lane);
    }
#undef IN
#undef SEAM
}

extern "C" void kernel_launch(void* const* d_in, const int* in_sizes, int n_in, void* d_out, int out_size, void* d_ws, size_t ws_size, hipStream_t stream) {
    static int grid = 0;
    if (grid == 0) {
        if (n_in != 17 || in_sizes[0] != S * DM || out_size != S * DM || ws_size < WS_END) {
            fprintf(stderr, "kernel_launch: shape/workspace mismatch: n_in %d in0 %d out %d ws %zu (need %zu)\n", n_in, n_in > 0 ? in_sizes[0] : -1, out_size, ws_size, (size_t)WS_END); grid = -1; return; }
        int dev = 0, cus = 0, per_cu = 0;
        if (hipGetDevice(&dev) != hipSuccess || hipDeviceGetAttribute(&cus, hipDeviceAttributeMultiprocessorCount, dev) != hipSuccess) { grid = -1; return; }
        if (hipFuncSetAttribute((const void*)mega_fwd, hipFuncAttributeMaxDynamicSharedMemorySize, LDS_BYTES) != hipSuccess) { fprintf(stderr, "kernel_launch: hipFuncSetAttribute failed\n"); grid = -1; return; }
        if (hipOccupancyMaxActiveBlocksPerMultiprocessor(&per_cu, (const void*)mega_fwd, NTHR, LDS_BYTES) != hipSuccess || per_cu < 1) per_cu = 1;
        (void)hipGetLastError();
        grid = cus * (per_cu > 1 ? 1 : per_cu);
    }
    if (grid < 0) return;
    if (hipMemsetAsync((char*)d_ws + WS_CTL, 0, CTL_ZERO_BYTES, stream) != hipSuccess) { fprintf(stderr, "kernel_launch: memset failed\n"); return; }
    Args a{};
    for (int i = 0; i < 17; ++i) a.in[i] = (const float*)d_in[i];
    a.out = (float*)d_out; a.ws = (unsigned char*)d_ws;
    if (MK_N_LAUNCHES == 1) {
        a.ph_lo = 0; a.ph_hi = NPH; void* kargs[] = {&a};
        hipError_t e = hipLaunchCooperativeKernel((const void*)mega_fwd, dim3(grid), dim3(NTHR), kargs, LDS_BYTES, stream);
        if (e != hipSuccess) fprintf(stderr, "kernel_launch: cooperative launch failed: %s (grid %d)\n", hipGetErrorString(e), grid);
    } else {
        for (int k = 0; k < NPH; ++k) { a.ph_lo = k; a.ph_hi = k + 1; hipLaunchKernelGGL(mega_fwd, dim3(grid), dim3(NTHR), LDS_BYTES, stream, a); }
    }
}
```

```cpp
#include <hip/hip_runtime.h>
#include <hip/hip_bf16.h>
#include <hip/hip_cooperative_groups.h>
#include <cstdio>
#include <cstdint>
#include <cmath>
namespace cg = cooperative_groups;
namespace pg8 {
#define PG8_LAS __attribute__((address_space(3)))
typedef unsigned short bf16_t;
typedef short bf16x8 __attribute__((ext_vector_type(8)));
typedef float f32x4 __attribute__((ext_vector_type(4)));
typedef unsigned u32x4 __attribute__((ext_vector_type(4)));
constexpr int BM = 256, BK = 64, HALF = 128, HTB = HALF * BK * 2  , STAGE_BYTES = 8 * HTB, NXCD = 8, WGM = 8;

__host__ __device__ __forceinline__ int lds_byte(int r, int c) { const int st = (r >> 4) * 2 + (c >> 5), rr = r & 15, cc = c & 31, ob = rr * 64 + cc * 2; return st * 1024 + (ob ^ (((ob >> 9) & 1) << 5)); }
__host__ __device__ __forceinline__ void stage_rc(int b, int& R, int& C) { const int st = b / 1024, sb = b % 1024, swz = sb ^ (((sb >> 9) & 1) << 5); R = (st >> 1) * 16 + swz / 64; C = (st & 1) * 32 + (swz % 64) / 2; }
__host__ __device__ __forceinline__ int perm32(int rho) { const int n = rho >> 4, i = rho & 15; return 8 * (i >> 2) + 4 * n + (i & 3); }

struct Unit { int pm, pn; };
struct Gemm { const bf16_t* A; const bf16_t* Bt; int M, N, K; };

struct StaticOrder {
    int nM, nN, nwg, G, c;
    __host__ __device__ void init(int M, int N, int G_, int c_) { nM = M / BM; nN = N / BM; nwg = nM * nN; G = G_; c = c_; }
    __host__ __device__ bool next(int i, Unit& u) const {
        const long L = (long)i * G + c; if (L >= nwg) return false;
        int wgid = (int)L; { const int q = nwg / NXCD, r = nwg % NXCD, xcd = wgid % NXCD, off = wgid / NXCD; wgid = (xcd < r ? xcd * (q + 1) : r * (q + 1) + (xcd - r) * q) + off; }
        const int nig = WGM * nN, gid = wgid / nig, fm = gid * WGM, gsz = (nM - fm) < WGM ? (nM - fm) : WGM;
        u.pm = fm + ((wgid % nig) % gsz); u.pn = (wgid % nig) / gsz; return true;
    }
    __device__ __forceinline__ void a_ready(const Unit&) const {}
    __device__ __forceinline__ void done(const Unit&) const {}
};

struct TailOrder {
    int nN, nwg, Gt, c;
    __host__ __device__ void init(int M, int N, int G_, int c_, int skip) { nN = N / BM; nwg = (M / BM) * nN; Gt = G_ - skip; c = c_ - skip; }
    __host__ __device__ bool next(int i, Unit& u) const { if (c < 0) return false; const long L = (long)i * Gt + c; if (L >= nwg) return false; u.pm = (int)L / nN; u.pn = (int)L % nN; return true; }
    __device__ __forceinline__ void a_ready(const Unit&) const {}
    __device__ __forceinline__ void done(const Unit&) const {}
};
__device__ __forceinline__ unsigned cvt_pk_bf16(float lo, float hi) { unsigned r; asm volatile("v_cvt_pk_bf16_f32 %0, %1, %2" : "=v"(r) : "v"(lo), "v"(hi)); return r; }
template <int ACT  , bool RS = false  > struct EpiBf16 {
    static constexpr bool PERM = true, AFTER_DRAIN = false;
    bf16_t* O; int ldc; const float* rs;
    __device__ __forceinline__ void prefetch(float (&pv)[8], const Unit& u, int wr, int fr) const {
        if constexpr (RS) { const float* p0 = rs + u.pm * BM + wr * 64 + fr;
#pragma unroll
            for (int i = 0; i < 8; ++i) { const float* p = p0 + (i >> 2) * HALF + (i & 3) * 16; asm volatile("global_load_dword %0, %1, off" : "=v"(pv[i]) : "v"(p) : "memory"); } }
        else {
#pragma unroll
            for (int i = 0; i < 8; ++i) pv[i] = 1.f; }
    }
    __device__ __forceinline__ void operator()(const f32x4 (&acc)[2][2][4][2], const Unit& u, int wr, int wc, int fr, int fq, const float (&pv)[8]) const {
        const int row0 = u.pm * BM + wr * 64 + fr; const int col0 = u.pn * BM + wc * 32 + 8 * fq;
#pragma unroll
        for (int ai = 0; ai < 2; ++ai)
#pragma unroll
            for (int m = 0; m < 4; ++m) { bf16_t* rowp = O + (size_t)(row0 + ai * HALF + m * 16) * ldc + col0; const float sc = RS ? pv[ai * 4 + m] : 1.f;
#pragma unroll
                for (int bj = 0; bj < 2; ++bj) { f32x4 v0 = acc[ai][bj][m][0] * sc, v1 = acc[ai][bj][m][1] * sc;
                    if (ACT == 2) {
#pragma unroll
                        for (int e = 0; e < 4; ++e) { float a = fmaxf(v0[e], 0.f), b = fmaxf(v1[e], 0.f); v0[e] = a * a; v1[e] = b * b; } }
                    if (ACT == 3) { const u32x4 ev = *(const u32x4*)(rowp + bj * HALF);
#pragma unroll
                        for (int e = 0; e < 2; ++e) { v0[2 * e] = __builtin_bit_cast(float, ev[e] << 16) * __builtin_amdgcn_rcpf(1.f + __expf(-v0[2 * e])); v0[2 * e + 1] = __builtin_bit_cast(float, ev[e] & 0xffff0000u) * __builtin_amdgcn_rcpf(1.f + __expf(-v0[2 * e + 1]));
                            v1[2 * e] = __builtin_bit_cast(float, ev[2 + e] << 16) * __builtin_amdgcn_rcpf(1.f + __expf(-v1[2 * e])); v1[2 * e + 1] = __builtin_bit_cast(float, ev[2 + e] & 0xffff0000u) * __builtin_amdgcn_rcpf(1.f + __expf(-v1[2 * e + 1])); } }
                    u32x4 w; w.x = cvt_pk_bf16(v0[0], v0[1]); w.y = cvt_pk_bf16(v0[2], v0[3]); w.z = cvt_pk_bf16(v1[0], v1[1]); w.w = cvt_pk_bf16(v1[2], v1[3]);
                    *(u32x4*)(rowp + bj * HALF) = w; } }
    }
};


template <class Epi, class Sched, bool ALIGN_EPI = false, bool SP2 = false>
__device__ __forceinline__ void gemm_phase(PG8_LAS unsigned char* lds, const Gemm g, const Sched& S, const Epi& E, int wave_s) {
    int lane_ = __builtin_amdgcn_mbcnt_hi(~0u, __builtin_amdgcn_mbcnt_lo(~0u, 0u)); asm volatile("" : "+v"(lane_));
    const int tid = wave_s * 64 + lane_, wid = __builtin_amdgcn_readfirstlane(tid >> 6), lane = tid & 63, wr = wid >> 2, wc = wid & 3, fr = lane & 15, fq = lane >> 4;
    const int K = g.K, nt = K / BK;
    unsigned voffA[2], voffB[2];
#pragma unroll
    for (int i = 0; i < 2; ++i) { int R, C; stage_rc(tid * 16 + i * 8192, R, C); const int Rb = Epi::PERM ? ((R & ~31) + perm32(R & 31)) : R;
        voffA[i] = (unsigned)(R * K + C) * 2u; voffB[i] = (unsigned)(Rb * K + C) * 2u; }
    const size_t kstep = (size_t)(BK * 2);
    const size_t hstep = (size_t)HALF * K * 2;
    const size_t tstep = 2 * hstep;
    const unsigned ldsw = (unsigned)wid * 1024u;
    const int aoff = lds_byte(wr * 64 + fr, fq * 8), boff = lds_byte(wc * 32 + fr, fq * 8);
#define PG8_SA(b, h) (((b) * 2 + (h)) * HTB)
#define PG8_SB(b, h) ((4 + (b) * 2 + (h)) * HTB)
#define PG8_STAGE(bufoff, gbase, voff) do { _Pragma("unroll") for (int _i = 0; _i < 2; ++_i) \
        __builtin_amdgcn_global_load_lds((const unsigned*)((const char*)(gbase) + (voff)[_i]), (PG8_LAS unsigned*)(lds + (bufoff) + ldsw + _i * 8192), 16, 0, 0); } while (0)
#define PG8_LDA(dst, b, h) do { _Pragma("unroll") for (int m = 0; m < 4; ++m) _Pragma("unroll") for (int k = 0; k < 2; ++k) dst[m][k] = *(const PG8_LAS bf16x8*)(lds + PG8_SA(b, h) + aoff + m * 2048 + k * 1024); } while (0)
#define PG8_LDB(dst, b, h) do { _Pragma("unroll") for (int n = 0; n < 2; ++n) _Pragma("unroll") for (int k = 0; k < 2; ++k) dst[n][k] = *(const PG8_LAS bf16x8*)(lds + PG8_SB(b, h) + boff + n * 2048 + k * 1024); } while (0)
#define PG8_MMA(ai, bj, At, Bt) do { __builtin_amdgcn_s_setprio(1); _Pragma("unroll") for (int m = 0; m < 4; ++m) _Pragma("unroll") for (int n = 0; n < 2; ++n) _Pragma("unroll") for (int k = 0; k < 2; ++k) \
        acc[ai][bj][m][n] = __builtin_amdgcn_mfma_f32_16x16x32_bf16(Bt[n][k], At[m][k], acc[ai][bj][m][n], 0, 0, 0); __builtin_amdgcn_s_setprio(0); } while (0)
#define PG8_WAIT_V(n) asm volatile("s_waitcnt vmcnt(" #n ")" ::: "memory")
#define PG8_WAIT_L(n) asm volatile("s_waitcnt lgkmcnt(" #n ")" ::: "memory")
#define PG8_BAR __builtin_amdgcn_s_barrier()
#define PG8_SCHED __builtin_amdgcn_sched_barrier(0)
    Unit cur, nxt; int ui = 0;
    if (!S.next(0, cur)) return;
    float pv[8]; E.prefetch(pv, cur, wr, fr);
    f32x4 acc[2][2][4][2];
#pragma unroll
    for (int a = 0; a < 2; ++a)
#pragma unroll
        for (int b = 0; b < 2; ++b)
#pragma unroll
            for (int m = 0; m < 4; ++m)
#pragma unroll
                for (int n = 0; n < 2; ++n) acc[a][b][m][n] = (f32x4){0.f, 0.f, 0.f, 0.f};
    bf16x8 At[4][2], B0[2][2], B1[2][2];
    const char* cA = (const char*)g.A + (size_t)cur.pm * tstep; const char* cB = (const char*)g.Bt + (size_t)cur.pn * tstep;
    S.a_ready(cur);
    if constexpr (SP2) {
        PG8_STAGE(PG8_SB(0, 0), cB, voffB); PG8_STAGE(PG8_SB(0, 1), cB + hstep, voffB); PG8_STAGE(PG8_SA(0, 0), cA, voffA); PG8_STAGE(PG8_SA(0, 1), cA + hstep, voffA);
        if (wr == 1) PG8_BAR;
        PG8_WAIT_V(2); PG8_BAR;
        PG8_STAGE(PG8_SB(1, 0), cB + kstep, voffB); PG8_STAGE(PG8_SA(1, 0), cA + kstep, voffA); PG8_STAGE(PG8_SB(1, 1), cB + hstep + kstep, voffB);
        PG8_WAIT_V(6); PG8_BAR;
    } else {
        PG8_STAGE(PG8_SB(0, 0), cB, voffB); PG8_STAGE(PG8_SA(0, 0), cA, voffA); PG8_STAGE(PG8_SB(0, 1), cB + hstep, voffB); PG8_STAGE(PG8_SA(0, 1), cA + hstep, voffA);
        if (wr == 1) PG8_BAR;
        PG8_WAIT_V(4); PG8_BAR;
        PG8_STAGE(PG8_SB(1, 0), cB + kstep, voffB); PG8_STAGE(PG8_SA(1, 0), cA + kstep, voffA); PG8_STAGE(PG8_SB(1, 1), cB + hstep + kstep, voffB);
        PG8_WAIT_V(6); PG8_BAR;
    }
    for (;;) {
        const bool has_next = S.next(ui + 1, nxt);
        const char* nA = has_next ? (const char*)g.A + (size_t)nxt.pm * tstep : cA; const char* nB = has_next ? (const char*)g.Bt + (size_t)nxt.pn * tstep : cB;
        for (int t = 0; t < nt; t += 2) {
            const bool last = (t == nt - 2);
            const char* a1 = cA + (size_t)(t + 1) * kstep;
            const char* a2 = last ? nA : cA + (size_t)(t + 2) * kstep; const char* b2 = last ? nB : cB + (size_t)(t + 2) * kstep;
            const char* a3 = a2 + kstep; const char* b3 = b2 + kstep;
            if (last && has_next) S.a_ready(nxt);
            if constexpr (SP2) {
            PG8_LDB(B0, 0, 0); PG8_LDB(B1, 0, 1); PG8_SCHED; PG8_LDA(At, 0, 0); PG8_STAGE(PG8_SA(1, 1), a1 + hstep, voffA);
            PG8_WAIT_V(8); PG8_WAIT_L(0); PG8_BAR; PG8_MMA(0, 0, At, B0); PG8_MMA(0, 1, At, B1); PG8_BAR; PG8_SCHED;
            PG8_LDA(At, 0, 1); PG8_STAGE(PG8_SB(0, 0), b2, voffB); PG8_STAGE(PG8_SB(0, 1), b2 + hstep, voffB); PG8_STAGE(PG8_SA(0, 0), a2, voffA);
            PG8_WAIT_V(8); PG8_WAIT_L(0); PG8_BAR; PG8_MMA(1, 0, At, B0); PG8_MMA(1, 1, At, B1); PG8_BAR; PG8_SCHED;
            PG8_LDB(B0, 1, 0); PG8_LDB(B1, 1, 1); PG8_SCHED; PG8_LDA(At, 1, 0); PG8_STAGE(PG8_SA(0, 1), a2 + hstep, voffA);
            PG8_WAIT_V(8); PG8_WAIT_L(0); PG8_BAR; PG8_MMA(0, 0, At, B0); PG8_MMA(0, 1, At, B1); PG8_BAR; PG8_SCHED;
            PG8_LDA(At, 1, 1); PG8_STAGE(PG8_SB(1, 0), b3, voffB); PG8_STAGE(PG8_SB(1, 1), b3 + hstep, voffB); PG8_STAGE(PG8_SA(1, 0), a3, voffA);
            PG8_WAIT_V(8); PG8_WAIT_L(0); PG8_BAR; PG8_MMA(1, 0, At, B0); PG8_MMA(1, 1, At, B1); PG8_BAR; PG8_SCHED;
            } else {
            PG8_LDB(B0, 0, 0); PG8_SCHED; PG8_LDA(At, 0, 0); PG8_STAGE(PG8_SA(1, 1), a1 + hstep, voffA);
            PG8_WAIT_L(8); PG8_BAR; PG8_WAIT_L(0); PG8_MMA(0, 0, At, B0); PG8_BAR; PG8_SCHED;
            PG8_LDB(B1, 0, 1); PG8_STAGE(PG8_SB(0, 0), b2, voffB);
            PG8_BAR; PG8_WAIT_L(0); PG8_MMA(0, 1, At, B1); PG8_BAR;
            PG8_LDA(At, 0, 1); PG8_STAGE(PG8_SA(0, 0), a2, voffA);
            PG8_BAR; PG8_WAIT_L(0); PG8_MMA(1, 0, At, B0); PG8_BAR; PG8_SCHED;
            PG8_STAGE(PG8_SB(0, 1), b2 + hstep, voffB);
            PG8_WAIT_V(6); PG8_BAR; PG8_MMA(1, 1, At, B1); PG8_BAR;
            PG8_LDB(B0, 1, 0); PG8_SCHED; PG8_LDA(At, 1, 0); PG8_STAGE(PG8_SA(0, 1), a2 + hstep, voffA);
            PG8_WAIT_L(8); PG8_BAR; PG8_WAIT_L(0); PG8_MMA(0, 0, At, B0); PG8_BAR; PG8_SCHED;
            PG8_LDB(B1, 1, 1); PG8_STAGE(PG8_SB(1, 0), b3, voffB);
            PG8_BAR; PG8_WAIT_L(0); PG8_MMA(0, 1, At, B1); PG8_BAR;
            PG8_LDA(At, 1, 1); PG8_STAGE(PG8_SA(1, 0), a3, voffA);
            PG8_BAR; PG8_WAIT_L(0); PG8_MMA(1, 0, At, B0); PG8_BAR; PG8_SCHED;
            PG8_STAGE(PG8_SB(1, 1), b3 + hstep, voffB);
            PG8_WAIT_V(6); PG8_BAR; PG8_MMA(1, 1, At, B1); PG8_BAR;
            }
        }
        if constexpr (ALIGN_EPI) { if (wr == 0) PG8_BAR; }
        if constexpr (!Epi::AFTER_DRAIN) { E(acc, cur, wr, wc, fr, fq, pv); S.done(cur); }
        if (!has_next) break;
#pragma unroll
        for (int a = 0; a < 2; ++a)
#pragma unroll
            for (int b = 0; b < 2; ++b)
#pragma unroll
                for (int m = 0; m < 4; ++m)
#pragma unroll
                    for (int n = 0; n < 2; ++n) acc[a][b][m][n] = (f32x4){0.f, 0.f, 0.f, 0.f};
        cur = nxt; cA = nA; cB = nB; ++ui;
        E.prefetch(pv, cur, wr, fr);
        if constexpr (ALIGN_EPI) { if (wr == 1) PG8_BAR; }
    }
    PG8_WAIT_V(0);
    if constexpr (!ALIGN_EPI) { if (wr == 0) PG8_BAR; }
    PG8_BAR;

#undef PG8_SA
#undef PG8_SB
#undef PG8_STAGE
#undef PG8_LDA
#undef PG8_LDB
#undef PG8_MMA
#undef PG8_WAIT_V
#undef PG8_WAIT_L
#undef PG8_BAR
#undef PG8_SCHED
}
}
namespace att {
using bf16 = __hip_bfloat16;
constexpr int   D = 128, NW = 8, QBLK = 32, KVBLK = 64;
constexpr float SCALE = 0.088388347648318440f;
constexpr float THR = 8.f;
#ifndef ATT_A_SDEPTH
#define ATT_A_SDEPTH 1
#endif
constexpr int SDEPTH = 2;
constexpr int LDQ = 4608, LDK = 4608, LDO = 2048;
constexpr size_t SHM_V = KVBLK * D * 2, SHM_K = KVBLK * D * 2, SHM_ATTN = 2 * SHM_V + 2 * SHM_K + NW * 64 * 4;
using bf16x8 = __attribute__((ext_vector_type(8))) short;
using s16x4  = __attribute__((ext_vector_type(4))) short;
using f32x16 = __attribute__((ext_vector_type(16))) float;
using f32x8  = __attribute__((ext_vector_type(8))) float;
using u32x4  = __attribute__((ext_vector_type(4))) unsigned;
#define KSWZ(row, colB) ((row) * 256 + ((colB) ^ (((row) & 7) << 4)))
#define SBAR() __builtin_amdgcn_sched_barrier(0)
__device__ __forceinline__ int crow(int r, int hi) { return (r & 3) + 8 * (r >> 2) + 4 * hi; }
__device__ __forceinline__ unsigned cvtpk(float lo, float hi) {
  unsigned r; asm volatile("v_cvt_pk_bf16_f32 %0, %1, %2" : "=v"(r) : "v"(lo), "v"(hi)); return r;
}
template <typename TIn> struct Stage;
template <> struct Stage<bf16>  { using T = bf16x8;
  __device__ static __forceinline__ T ld8(const bf16* p) { return *reinterpret_cast<const bf16x8*>(p); }
  __device__ static __forceinline__ bf16x8 tobf(T x) { return x; } };
template <> struct Stage<float> { using T = f32x8;
  __device__ static __forceinline__ T ld8(const float* p) { return *reinterpret_cast<const f32x8*>(p); }
  __device__ static __forceinline__ bf16x8 tobf(T x) {
    u32x4 w = {cvtpk(x[0], x[1]), cvtpk(x[2], x[3]), cvtpk(x[4], x[5]), cvtpk(x[6], x[7])}; return *reinterpret_cast<bf16x8*>(&w); } };

__device__ __forceinline__ void partialSM(f32x16& p0, f32x16& p1, float& m_reg, float& mn, float& alpha) {
  constexpr float C = SCALE * 1.4426950408889634f;
  float pmax = p0[0]; for (int r = 1; r < 16; ++r) pmax = fmaxf(pmax, p0[r]); for (int r = 0; r < 16; ++r) pmax = fmaxf(pmax, p1[r]);
  { auto rr = __builtin_amdgcn_permlane32_swap(__float_as_uint(pmax), __float_as_uint(pmax), false, false);
    pmax = fmaxf(__uint_as_float(rr[0]), __uint_as_float(rr[1])); }
  if (__builtin_expect(__all(pmax - m_reg <= THR / SCALE), 1)) { mn = m_reg; alpha = 1.f; }
  else { mn = fmaxf(m_reg, pmax); alpha = __builtin_amdgcn_exp2f((m_reg - mn) * C); m_reg = mn; }
  float mnC = -mn * C;
  for (int r = 0; r < 16; ++r) p0[r] = fmaf(p0[r], C, mnC); for (int r = 0; r < 16; ++r) p1[r] = fmaf(p1[r], C, mnC);
  for (int r = 0; r < 16; ++r) p0[r] = __builtin_amdgcn_exp2f(p0[r]);
}
__device__ __forceinline__ void finishSM(f32x16& p0, f32x16& p1, float alpha, float& l_reg, bf16x8& pa0, bf16x8& pa1, bf16x8& pa2, bf16x8& pa3) {
  for (int r = 0; r < 16; ++r) p1[r] = __builtin_amdgcn_exp2f(p1[r]);
  float ps = 0; for (int r = 0; r < 16; ++r) ps += p0[r]; for (int r = 0; r < 16; ++r) ps += p1[r];
  { auto rr = __builtin_amdgcn_permlane32_swap(__float_as_uint(ps), __float_as_uint(ps), false, false);
    ps = __uint_as_float(rr[0]) + __uint_as_float(rr[1]); }
  l_reg = l_reg * alpha + ps;
#define PK4(P, BASE, OUT) do { unsigned a0 = cvtpk(P[BASE + 0], P[BASE + 1]), a1 = cvtpk(P[BASE + 2], P[BASE + 3]);   \
    unsigned b0 = cvtpk(P[BASE + 4], P[BASE + 5]), b1 = cvtpk(P[BASE + 6], P[BASE + 7]);                              \
    auto r0 = __builtin_amdgcn_permlane32_swap(a0, b0, false, false); auto r1 = __builtin_amdgcn_permlane32_swap(a1, b1, false, false); \
    u32x4 w = {r0[0], r1[0], r0[1], r1[1]}; OUT = *reinterpret_cast<bf16x8*>(&w); } while (0)
  PK4(p0, 0, pa0); PK4(p0, 8, pa1); PK4(p1, 0, pa2); PK4(p1, 8, pa3);
#undef PK4
}
__device__ __forceinline__ void qkt(f32x16& p0, f32x16& p1, const bf16* Ks, const bf16x8* qr, int r32, int hi) {
  p0 = f32x16{}; p1 = f32x16{};
  for (int d0 = 0; d0 < 8; ++d0) { int cb = (d0 * 16 + hi * 8) * 2;
    bf16x8 b0 = *reinterpret_cast<const bf16x8*>((const char*)Ks + KSWZ(r32, cb));
    bf16x8 b1 = *reinterpret_cast<const bf16x8*>((const char*)Ks + KSWZ(32 + r32, cb));
    p0 = __builtin_amdgcn_mfma_f32_32x32x16_bf16(b0, qr[d0], p0, 0, 0, 0);
    p1 = __builtin_amdgcn_mfma_f32_32x32x16_bf16(b1, qr[d0], p1, 0, 0, 0); }
}
__device__ __forceinline__ int v_st(int k, int c) { const int kk = (k & ~0xC) | ((k & 4) << 1) | ((k & 8) >> 1); return ((kk >> 3) * 4 + (c >> 5)) * 512 + ((kk & 7) * 32 + (c & 31)) * 2; }
__device__ __forceinline__ int v_rd_base(int lane) { return ((lane & 3) << 3) | (((lane >> 2) & 3) << 6) | (((lane >> 4) & 1) << 5) | (((lane >> 5) & 1) << 8); }
constexpr int v_rd_off(int d0, int ks, int half) { return d0 * 512 + ks * 4096 + half * 2048; }
template <int OFF> __device__ __forceinline__ s16x4 tr_read(int vb) {
  s16x4 r; asm volatile("ds_read_b64_tr_b16 %0, %1 offset:%2" : "=&v"(r) : "v"(vb), "i"(OFF) : "memory"); return r;
}
template <int D0> __device__ __forceinline__ void pv_one(f32x16& od, int vb, bf16x8 pa0, bf16x8 pa1, bf16x8 pa2, bf16x8 pa3) {
  const s16x4 l0 = tr_read<v_rd_off(D0, 0, 0)>(vb), h0 = tr_read<v_rd_off(D0, 0, 1)>(vb), l1 = tr_read<v_rd_off(D0, 1, 0)>(vb), h1 = tr_read<v_rd_off(D0, 1, 1)>(vb);
  const s16x4 l2 = tr_read<v_rd_off(D0, 2, 0)>(vb), h2 = tr_read<v_rd_off(D0, 2, 1)>(vb), l3 = tr_read<v_rd_off(D0, 3, 0)>(vb), h3 = tr_read<v_rd_off(D0, 3, 1)>(vb);
  asm volatile("s_waitcnt lgkmcnt(0)" ::: "memory"); SBAR();
#define PK(L, H) (bf16x8){L[0], L[1], L[2], L[3], H[0], H[1], H[2], H[3]}
  od = __builtin_amdgcn_mfma_f32_32x32x16_bf16(pa0, PK(l0, h0), od, 0, 0, 0);
  od = __builtin_amdgcn_mfma_f32_32x32x16_bf16(pa1, PK(l1, h1), od, 0, 0, 0);
  od = __builtin_amdgcn_mfma_f32_32x32x16_bf16(pa2, PK(l2, h2), od, 0, 0, 0);
  od = __builtin_amdgcn_mfma_f32_32x32x16_bf16(pa3, PK(l3, h3), od, 0, 0, 0);
#undef PK
}
__device__ __forceinline__ void pv_d0(f32x16* o, int vb, bf16x8 pa0, bf16x8 pa1, bf16x8 pa2, bf16x8 pa3) {
  pv_one<0>(o[0], vb, pa0, pa1, pa2, pa3); pv_one<1>(o[1], vb, pa0, pa1, pa2, pa3); pv_one<2>(o[2], vb, pa0, pa1, pa2, pa3); pv_one<3>(o[3], vb, pa0, pa1, pa2, pa3);
}


typedef const __attribute__((address_space(3))) float* lds_cf;
__device__ __forceinline__ void nbmask(f32x16& p0, f32x16& p1, int kr, int rq, int cq, int hi, lds_cf tbl) {
  int r0 = rq - 4; r0 = r0 < 0 ? 0 : (r0 > 248 ? 248 : r0);
  int c0 = cq - 8; c0 = c0 < 0 ? 0 : (c0 > 48 ? 48 : c0);
  const bool row_ok = (unsigned)(kr - r0) < 8u;
  const unsigned long long cm = row_ok ? ((0xFFFFull << c0) >> (4 * hi)) : 0ull;
  const unsigned mlo = (unsigned)cm, mhi = (unsigned)(cm >> 32);
  const int dr = row_ok ? kr - rq + 7 : 0;
  lds_cf tb = tbl + (dr * 128 + 63 - cq + 4 * hi);
#pragma unroll
  for (int r = 0; r < 16; ++r) {
    const int bit = (r & 3) + 8 * (r >> 2);
    float b0 = tb[bit], b1 = tb[bit + 32]; asm volatile("" : "+v"(b0), "+v"(b1));
    p0[r] = (mlo & (1u << bit)) ? p0[r] + b0 : -INFINITY; p1[r] = (mhi & (1u << bit)) ? p1[r] + b1 : -INFINITY;
  }
}
#define PVRD(D0, L) do { L[0] = tr_read<v_rd_off(D0, 0, 0)>(vb); L[1] = tr_read<v_rd_off(D0, 0, 1)>(vb); L[2] = tr_read<v_rd_off(D0, 1, 0)>(vb); L[3] = tr_read<v_rd_off(D0, 1, 1)>(vb); \
    L[4] = tr_read<v_rd_off(D0, 2, 0)>(vb); L[5] = tr_read<v_rd_off(D0, 2, 1)>(vb); L[6] = tr_read<v_rd_off(D0, 3, 0)>(vb); L[7] = tr_read<v_rd_off(D0, 3, 1)>(vb); } while (0)
#define PVMM(OD, L) do { OD = __builtin_amdgcn_mfma_f32_32x32x16_bf16(pa0, PKV(L[0], L[1]), OD, 0, 0, 0); OD = __builtin_amdgcn_mfma_f32_32x32x16_bf16(pa1, PKV(L[2], L[3]), OD, 0, 0, 0); \
    OD = __builtin_amdgcn_mfma_f32_32x32x16_bf16(pa2, PKV(L[4], L[5]), OD, 0, 0, 0); OD = __builtin_amdgcn_mfma_f32_32x32x16_bf16(pa3, PKV(L[6], L[7]), OD, 0, 0, 0); } while (0)
#define PKV(L, H) (bf16x8){L[0], L[1], L[2], L[3], H[0], H[1], H[2], H[3]}
__device__ __forceinline__ void pv_d0p(f32x16* o, int vb, bf16x8 pa0, bf16x8 pa1, bf16x8 pa2, bf16x8 pa3) {
  s16x4 a[8], b[8];
  PVRD(0, a); PVRD(1, b); asm volatile("s_waitcnt lgkmcnt(8)" ::: "memory"); SBAR(); PVMM(o[0], a);
  PVRD(2, a); asm volatile("s_waitcnt lgkmcnt(8)" ::: "memory"); SBAR(); PVMM(o[1], b);
  PVRD(3, b); asm volatile("s_waitcnt lgkmcnt(8)" ::: "memory"); SBAR(); PVMM(o[2], a);
  asm volatile("s_waitcnt lgkmcnt(0)" ::: "memory"); SBAR(); PVMM(o[3], b);
}
#undef PVRD
#undef PVMM
#undef PKV
#define PVRDK(KS, L) do { L[0] = tr_read<v_rd_off(0, KS, 0)>(vb); L[1] = tr_read<v_rd_off(0, KS, 1)>(vb); L[2] = tr_read<v_rd_off(1, KS, 0)>(vb); L[3] = tr_read<v_rd_off(1, KS, 1)>(vb); \
    L[4] = tr_read<v_rd_off(2, KS, 0)>(vb); L[5] = tr_read<v_rd_off(2, KS, 1)>(vb); L[6] = tr_read<v_rd_off(3, KS, 0)>(vb); L[7] = tr_read<v_rd_off(3, KS, 1)>(vb); } while (0)
#define PKV(L, H) (bf16x8){L[0], L[1], L[2], L[3], H[0], H[1], H[2], H[3]}
#define PVMMK(PA, L) do { o[0] = __builtin_amdgcn_mfma_f32_32x32x16_bf16(PA, PKV(L[0], L[1]), o[0], 0, 0, 0); o[1] = __builtin_amdgcn_mfma_f32_32x32x16_bf16(PA, PKV(L[2], L[3]), o[1], 0, 0, 0); \
    o[2] = __builtin_amdgcn_mfma_f32_32x32x16_bf16(PA, PKV(L[4], L[5]), o[2], 0, 0, 0); o[3] = __builtin_amdgcn_mfma_f32_32x32x16_bf16(PA, PKV(L[6], L[7]), o[3], 0, 0, 0); } while (0)
__device__ __forceinline__ void pv_ks(f32x16* o, int vb, bf16x8 pa0, bf16x8 pa1, bf16x8 pa2, bf16x8 pa3) {
  s16x4 a[8], b[8];
  PVRDK(0, a); PVRDK(1, b); asm volatile("s_waitcnt lgkmcnt(8)" ::: "memory"); SBAR(); PVMMK(pa0, a);
  PVRDK(2, a); asm volatile("s_waitcnt lgkmcnt(8)" ::: "memory"); SBAR(); PVMMK(pa1, b);
  PVRDK(3, b); asm volatile("s_waitcnt lgkmcnt(8)" ::: "memory"); SBAR(); PVMMK(pa2, a);
  asm volatile("s_waitcnt lgkmcnt(0)" ::: "memory"); SBAR(); PVMMK(pa3, b);
}
#undef PVRDK
#undef PKV
#undef PVMMK
__device__ __forceinline__ void store_o_staged(const f32x16* o, const float* rli, bf16* Ow, char* stage, int lane) {
  const int r32 = lane & 31, hi = lane >> 5;
#pragma unroll
  for (int r = 0; r < 16; ++r) { const int orow = crow(r, hi);
#pragma unroll
    for (int d0 = 0; d0 < 4; ++d0) *(bf16*)(stage + orow * 256 + (d0 * 32 + r32) * 2) = __float2bfloat16(o[d0][r] * rli[r]); }
  asm volatile("s_waitcnt lgkmcnt(0)" ::: "memory");
#pragma unroll
  for (int k = 0; k < 8; ++k) { const int row = (lane >> 4) + 4 * k; const u32x4 v = *(const u32x4*)(stage + row * 256 + (lane & 15) * 16); *(u32x4*)(Ow + (long)row * LDO + (lane & 15) * 8) = v; }
}
template <bool NB>
__device__ __forceinline__ void attn_dense_body(const bf16* __restrict__ Qb, const bf16* __restrict__ Kh, const bf16* __restrict__ Vh,
                                                bf16* __restrict__ Ob, int seq, char* lds, int tq0, int krow0, int wave_s) {
  using TQ = bf16; constexpr int SDEPTH = NB ? 2 : ATT_A_SDEPTH;
  using St = Stage<bf16>; using SQ = Stage<TQ>;
  int tid_ = __builtin_amdgcn_mbcnt_hi(~0u, __builtin_amdgcn_mbcnt_lo(~0u, 0u)); asm volatile("" : "+v"(tid_)); tid_ += wave_s * 64;
  const int tid = tid_, wid = tid >> 6, lane = tid & 63, r32 = lane & 31, hi = lane >> 5;
  bf16* V_lds = (bf16*)lds; bf16* K_lds = (bf16*)(lds + 2 * SHM_V);
  float* ws = (float*)(lds + 2 * SHM_V + 2 * SHM_K) + wid * 64; float* li_l = ws; float* al_l = ws + 32;
  float m_reg = -1e30f, l_reg = 0; f32x16 o[4] = {}; bf16x8 qr[8];
  lds_cf tbl = (lds_cf)(__attribute__((address_space(3))) char*)(lds + SHM_ATTN);
  const int nb_tq = tq0 + wid * QBLK + r32, nb_rq = nb_tq >> 6, nb_cq = nb_tq & 63;
  const TQ* Qw = Qb + (long)(wid * QBLK + r32) * LDQ + hi * 8;
#pragma unroll
  for (int d0 = 0; d0 < 8; ++d0) qr[d0] = SQ::tobf(SQ::ld8(Qw + d0 * 16));
  const int sr = tid >> 4, sc = (tid & 15) * 8, vst0 = v_st(sr, sc), vst1 = v_st(32 + sr, sc);
  const int vb0 = (int)(uintptr_t)V_lds + v_rd_base(lane);
  struct { typename St::T vs0, vs1, ks0, ks1; } sr_[SDEPTH];
#define SLOAD(i, k0) do { sr_[i].vs0 = St::ld8(&Vh[(long)((k0) + sr) * LDK + sc]); sr_[i].vs1 = St::ld8(&Vh[(long)((k0) + 32 + sr) * LDK + sc]); \
    sr_[i].ks0 = St::ld8(&Kh[(long)((k0) + sr) * LDK + sc]); sr_[i].ks1 = St::ld8(&Kh[(long)((k0) + 32 + sr) * LDK + sc]); } while (0)
#define SWRITE(b, i) do { *(bf16x8*)((char*)V_lds + (b) * SHM_V + vst0) = St::tobf(sr_[i].vs0);          \
    *(bf16x8*)((char*)V_lds + (b) * SHM_V + vst1) = St::tobf(sr_[i].vs1); int kc = sc * 2;               \
    *(bf16x8*)((char*)K_lds + (b) * SHM_K + KSWZ(sr, kc)) = St::tobf(sr_[i].ks0);                       \
    *(bf16x8*)((char*)K_lds + (b) * SHM_K + KSWZ(32 + sr, kc)) = St::tobf(sr_[i].ks1); } while (0)
#define SWAIT() do { if constexpr (SDEPTH == 2) asm volatile("s_waitcnt vmcnt(4)" ::: "memory"); else asm volatile("s_waitcnt vmcnt(0)" ::: "memory"); } while (0)
#define RESC(a) do { if (__any((a) < 1.f)) { if (hi == 0) al_l[r32] = (a); asm volatile("s_waitcnt lgkmcnt(0)" ::: "memory"); \
    for (int d = 0; d < 4; ++d) for (int r = 0; r < 16; ++r) o[d][r] *= al_l[crow(r, hi)]; } } while (0)
  f32x16 pA0, pA1, pB0, pB1; float mnA, mnB, alA, alB; bf16x8 pa0, pa1, pa2, pa3; const int NT = seq / KVBLK;
  if constexpr (NB) {
    int r0w = __builtin_amdgcn_readfirstlane((tq0 + wid * QBLK) >> 6) - 4; r0w = r0w < 0 ? 0 : (r0w > 248 ? 248 : r0w);
    SLOAD(0, 0); asm volatile("s_waitcnt vmcnt(0)" ::: "memory"); SWRITE(0, 0); __syncthreads();
    SLOAD(1, KVBLK);
#define NBSTEP(t, bsel) do { if ((unsigned)(krow0 + (t) - r0w) < 8u) {   \
        SBAR(); qkt(pA0, pA1, (bf16*)((char*)K_lds + (bsel) * SHM_K), qr, r32, hi); nbmask(pA0, pA1, krow0 + (t), nb_rq, nb_cq, hi, tbl); \
        partialSM(pA0, pA1, m_reg, mnA, alA); RESC(alA); \
        finishSM(pA0, pA1, alA, l_reg, pa0, pa1, pa2, pa3); SBAR(); \
        pv_d0(o, vb0 + (bsel) * (int)SHM_V, pa0, pa1, pa2, pa3); } } while (0)
    for (int t = 0; t < NT; t += 2) {
      if (t + 2 < NT) SLOAD(0, (t + 2) * KVBLK);
      NBSTEP(t, 0);
      SWRITE(1, 1); __syncthreads();
      if (t + 3 < NT) SLOAD(1, (t + 3) * KVBLK);
      NBSTEP(t + 1, 1);
      if (t + 2 < NT) SWRITE(0, 0);
      __syncthreads();
    }
#undef NBSTEP
  } else {
  constexpr int SE = 0, SO = SDEPTH - 1;
  SLOAD(SE, 0); asm volatile("s_waitcnt vmcnt(0)" ::: "memory"); SWRITE(0, SE); __syncthreads();
  qkt(pA0, pA1, K_lds, qr, r32, hi); partialSM(pA0, pA1, m_reg, mnA, alA);
  SLOAD(SO, KVBLK); if constexpr (SDEPTH == 2) { if (2 < NT) SLOAD(SE, 2 * KVBLK); }
  SWAIT(); SWRITE(1, SO); __syncthreads();
  for (int j = 1; j + 1 < NT; j += 2) {
    SBAR(); qkt(pB0, pB1, (bf16*)((char*)K_lds + SHM_K), qr, r32, hi);
    finishSM(pA0, pA1, alA, l_reg, pa0, pa1, pa2, pa3); SBAR();
    SLOAD(SO, (j + SDEPTH) * KVBLK); SBAR();
    pv_d0(o, vb0, pa0, pa1, pa2, pa3); partialSM(pB0, pB1, m_reg, mnB, alB);
    __syncthreads(); SWAIT(); SWRITE(0, SE);
    RESC(alB); __syncthreads();
    SBAR(); qkt(pA0, pA1, K_lds, qr, r32, hi);
    finishSM(pB0, pB1, alB, l_reg, pa0, pa1, pa2, pa3); SBAR();
    if (SDEPTH == 1 || j + 3 < NT) SLOAD(SE, (j + 1 + SDEPTH) * KVBLK); SBAR();
    pv_d0(o, vb0 + (int)SHM_V, pa0, pa1, pa2, pa3); partialSM(pA0, pA1, m_reg, mnA, alA);
    __syncthreads(); SWAIT(); SWRITE(1, SO);
    RESC(alA); __syncthreads();
  }
  SBAR(); qkt(pB0, pB1, (bf16*)((char*)K_lds + SHM_K), qr, r32, hi);
  finishSM(pA0, pA1, alA, l_reg, pa0, pa1, pa2, pa3); SBAR();
  pv_d0(o, vb0, pa0, pa1, pa2, pa3); partialSM(pB0, pB1, m_reg, mnB, alB);
  __syncthreads(); RESC(alB);
  finishSM(pB0, pB1, alB, l_reg, pa0, pa1, pa2, pa3); SBAR();
  pv_d0(o, vb0 + (int)SHM_V, pa0, pa1, pa2, pa3);
  }
  if (hi == 0) li_l[r32] = l_reg; asm volatile("s_waitcnt lgkmcnt(0)" ::: "memory");
  float rli[16];
#pragma unroll
  for (int r = 0; r < 16; ++r) rli[r] = __builtin_amdgcn_rcpf(li_l[crow(r, hi)]);
  bf16* Ow = Ob + (long)(wid * QBLK) * LDO;
  __syncthreads();
  store_o_staged(o, rli, Ow, lds + wid * 8192, lane);
  __syncthreads();
#undef SLOAD
#undef SWRITE
#undef SWAIT
#undef RESC
}

constexpr int RING = 3, DMA_K0 = 0, DMA_V0 = RING * (int)SHM_K, DMA_WS = 2 * RING * (int)SHM_K; constexpr int PP_TBL = DMA_WS + 2048;
#define DMA16(gp, loff) __builtin_amdgcn_global_load_lds((const unsigned*)(gp), (__attribute__((address_space(3))) unsigned*)((__attribute__((address_space(3))) char*)lds_as + (loff)), 16, 0, 0)
__device__ __forceinline__ void attn_dense_dma(const bf16* __restrict__ Qb, const bf16* __restrict__ Kh, const bf16* __restrict__ Vh, bf16* __restrict__ Ob, int seq, char* lds, int wave_s) {
  int tid_ = __builtin_amdgcn_mbcnt_hi(~0u, __builtin_amdgcn_mbcnt_lo(~0u, 0u)); asm volatile("" : "+v"(tid_));
  const int lane = tid_, wid = wave_s, r32 = lane & 31, hi = lane >> 5;
  __attribute__((address_space(3))) char* lds_as = (__attribute__((address_space(3))) char*)lds;
  float* ws = (float*)(lds + DMA_WS) + wid * 64; float* li_l = ws; float* al_l = ws + 32;
  float m_reg = -1e30f, l_reg = 0; f32x16 o[4] = {}; bf16x8 qr[8];
  const bf16* Qw = Qb + (long)(wid * QBLK + r32) * LDQ + hi * 8;
#pragma unroll
  for (int d0 = 0; d0 < 8; ++d0) qr[d0] = *reinterpret_cast<const bf16x8*>(Qw + d0 * 16);
  unsigned koff[2], voff[2];
#pragma unroll
  for (int q = 0; q < 2; ++q) { const int P = wid * 2 + q;
    { const int row = 4 * P + (lane >> 4), c = (lane & 15) ^ (row & 7); koff[q] = (unsigned)(row * LDK + c * 8) * 2u; }
    { const int sI = 2 * P + (lane >> 5), ch = lane & 31, kk = (sI >> 2) * 8 + (ch >> 2), cc = (sI & 3) * 32 + (ch & 3) * 8, k = (kk & ~0xC) | ((kk & 4) << 1) | ((kk & 8) >> 1); voff[q] = (unsigned)(k * LDK + cc) * 2u; } }
  const int pbase = wid * 2048;
  const int NT = seq / KVBLK; const size_t tstep = (size_t)KVBLK * LDK * 2;
#define DMA_K(t, slot) do { const char* g_ = (const char*)Kh + (size_t)(t) * tstep; DMA16(g_ + koff[0], DMA_K0 + (slot) * (int)SHM_K + pbase); DMA16(g_ + koff[1], DMA_K0 + (slot) * (int)SHM_K + pbase + 1024); } while (0)
#define DMA_V(t, slot) do { const char* g_ = (const char*)Vh + (size_t)(t) * tstep; DMA16(g_ + voff[0], DMA_V0 + (slot) * (int)SHM_V + pbase); DMA16(g_ + voff[1], DMA_V0 + (slot) * (int)SHM_V + pbase + 1024); } while (0)
#define STEP_END() do { asm volatile("s_waitcnt vmcnt(4) lgkmcnt(0)" ::: "memory"); __builtin_amdgcn_s_barrier(); asm volatile("" ::: "memory"); } while (0)
#define RESC(a) do { if (__any((a) < 1.f)) { if (hi == 0) al_l[r32] = (a); asm volatile("s_waitcnt lgkmcnt(0)" ::: "memory"); \
    for (int d = 0; d < 4; ++d) for (int r = 0; r < 16; ++r) o[d][r] *= al_l[crow(r, hi)]; } } while (0)
#define KPTR(slot) ((const bf16*)(lds + DMA_K0 + (slot) * (int)SHM_K))
  const int vb0 = (int)(uintptr_t)(lds + DMA_V0) + v_rd_base(lane);
  f32x16 pA0, pA1, pB0, pB1; float mnA, mnB, alA, alB; bf16x8 pa0, pa1, pa2, pa3;
  DMA_K(0, 0); DMA_V(0, 0); DMA_K(1, 1);
  asm volatile("s_waitcnt vmcnt(2)" ::: "memory"); __builtin_amdgcn_s_barrier(); asm volatile("" ::: "memory");
  DMA_K(2, 2); DMA_V(1, 1);
  SBAR(); qkt(pA0, pA1, KPTR(0), qr, r32, hi); partialSM(pA0, pA1, m_reg, mnA, alA);
  STEP_END();
  int s0 = 1, s1 = 2, s2 = 0;
  for (int j = 1; j + 1 < NT; j += 2) {
    { const int tk = j + 2 < NT ? j + 2 : NT - 1; DMA_K(tk, s2); DMA_V(j + 1, s1); }
    SBAR(); qkt(pB0, pB1, KPTR(s0), qr, r32, hi);
    finishSM(pA0, pA1, alA, l_reg, pa0, pa1, pa2, pa3); SBAR();
    pv_d0p(o, vb0 + s2 * (int)SHM_V, pa0, pa1, pa2, pa3);
    partialSM(pB0, pB1, m_reg, mnB, alB); RESC(alB);
    STEP_END();
    { const int tk = j + 3 < NT ? j + 3 : NT - 1, tv = j + 2 < NT ? j + 2 : NT - 1; DMA_K(tk, s0); DMA_V(tv, s2); }
    SBAR(); qkt(pA0, pA1, KPTR(s1), qr, r32, hi);
    finishSM(pB0, pB1, alB, l_reg, pa0, pa1, pa2, pa3); SBAR();
    pv_d0p(o, vb0 + s0 * (int)SHM_V, pa0, pa1, pa2, pa3);
    partialSM(pA0, pA1, m_reg, mnA, alA); RESC(alA);
    STEP_END();
    { const int t_ = s0; s0 = s2; s2 = s1; s1 = t_; }
  }
  SBAR(); qkt(pB0, pB1, KPTR(s0), qr, r32, hi);
  finishSM(pA0, pA1, alA, l_reg, pa0, pa1, pa2, pa3); SBAR();
  pv_d0p(o, vb0 + s2 * (int)SHM_V, pa0, pa1, pa2, pa3);
  partialSM(pB0, pB1, m_reg, mnB, alB); RESC(alB);
  finishSM(pB0, pB1, alB, l_reg, pa0, pa1, pa2, pa3);
  asm volatile("s_waitcnt vmcnt(0) lgkmcnt(0)" ::: "memory"); __builtin_amdgcn_s_barrier(); asm volatile("" ::: "memory"); SBAR();
  pv_d0p(o, vb0 + s0 * (int)SHM_V, pa0, pa1, pa2, pa3);
  if (hi == 0) li_l[r32] = l_reg; asm volatile("s_waitcnt lgkmcnt(0)" ::: "memory");
  float rli[16];
#pragma unroll
  for (int r = 0; r < 16; ++r) rli[r] = __builtin_amdgcn_rcpf(li_l[crow(r, hi)]);
  bf16* Ow = Ob + (long)(wid * QBLK) * LDO;
#pragma unroll
  for (int r = 0; r < 16; ++r) { int orow = crow(r, hi);
    for (int d0 = 0; d0 < 4; ++d0) Ow[(long)orow * LDO + d0 * 32 + r32] = __float2bfloat16(o[d0][r] * rli[r]); }
  asm volatile("s_waitcnt lgkmcnt(0)" ::: "memory"); __builtin_amdgcn_s_barrier(); asm volatile("" ::: "memory");
#undef DMA_K
#undef DMA_V
#undef STEP_END
#undef RESC
#undef KPTR
}
#undef DMA16


template <int OFF> __device__ __forceinline__ bf16x8 k_read(int addr) { bf16x8 r; asm volatile("ds_read_b128 %0, %1 offset:%2" : "=&v"(r) : "v"(addr), "i"(OFF) : "memory"); return r; }
#define KRD(D0, X0, X1) do { X0 = k_read<((D0) >> 2) * 128>(ka[(D0) & 3]); X1 = k_read<((D0) >> 2) * 128 + 8192>(ka[(D0) & 3]); } while (0)
#define KMM(D0, X0, X1) do { p0 = __builtin_amdgcn_mfma_f32_32x32x16_bf16(X0, qr[D0], p0, 0, 0, 0); p1 = __builtin_amdgcn_mfma_f32_32x32x16_bf16(X1, qr[D0], p1, 0, 0, 0); } while (0)
#define KW(N) do { asm volatile("s_waitcnt lgkmcnt(" #N ")" ::: "memory"); SBAR(); } while (0)
struct KFr { bf16x8 a0, a1, b0, b1, c0, c1; };
__device__ __forceinline__ void qkt_p_begin(KFr& f, const int (&ka)[4]) { KRD(0, f.a0, f.a1); KRD(1, f.b0, f.b1); KRD(2, f.c0, f.c1); }
__device__ __forceinline__ void qkt_p_rest(KFr& f, f32x16& p0, f32x16& p1, const int (&ka)[4], const bf16x8* qr) {
  p0 = f32x16{}; p1 = f32x16{};
  KW(4); KMM(0, f.a0, f.a1); KRD(3, f.a0, f.a1);
  KW(4); KMM(1, f.b0, f.b1); KRD(4, f.b0, f.b1);
  KW(4); KMM(2, f.c0, f.c1); KRD(5, f.c0, f.c1);
  KW(4); KMM(3, f.a0, f.a1); KRD(6, f.a0, f.a1);
  KW(4); KMM(4, f.b0, f.b1); KRD(7, f.b0, f.b1);
  KW(4); KMM(5, f.c0, f.c1);
  KW(2); KMM(6, f.a0, f.a1);
  KW(0); KMM(7, f.b0, f.b1);
}
#undef KRD
#undef KMM
#undef KW
#define DMA16(gp, loff) __builtin_amdgcn_global_load_lds((const unsigned*)(gp), (__attribute__((address_space(3))) unsigned*)((__attribute__((address_space(3))) char*)lds_as + (loff)), 16, 0, 0)
template <bool NB>
__device__ __forceinline__ void attn_dense_pp(const bf16* __restrict__ Qb, const bf16* __restrict__ Kh, const bf16* __restrict__ Vh, bf16* __restrict__ Ob, int seq, char* lds, int wave_s, const float* __restrict__ gq, int tq0, int krow0) {
  int tid_ = __builtin_amdgcn_mbcnt_hi(~0u, __builtin_amdgcn_mbcnt_lo(~0u, 0u)); asm volatile("" : "+v"(tid_));
  const int lane = tid_, wid = wave_s, r32 = lane & 31, hi = lane >> 5;
  __attribute__((address_space(3))) char* lds_as = (__attribute__((address_space(3))) char*)lds;
  float* ws = (float*)(lds + DMA_WS) + wid * 64; float* li_l = ws; float* al_l = ws + 32;
  float m_reg = -1e30f, l_reg = 0; f32x16 o[4] = {}; bf16x8 qr[8];
  const bf16* Qw = Qb + (long)(wid * QBLK + r32) * LDQ + hi * 8;
#pragma unroll
  for (int d0 = 0; d0 < 8; ++d0) qr[d0] = *reinterpret_cast<const bf16x8*>(Qw + d0 * 16);
  if constexpr (!NB) { float qf[8][8]; float ss = 0.f;
#pragma unroll
    for (int d0 = 0; d0 < 8; ++d0)
#pragma unroll
      for (int e = 0; e < 8; ++e) { qf[d0][e] = __builtin_bit_cast(float, (unsigned)(unsigned short)qr[d0][e] << 16); ss += qf[d0][e] * qf[d0][e]; }
    { auto rr = __builtin_amdgcn_permlane32_swap(__float_as_uint(ss), __float_as_uint(ss), false, false); ss = __uint_as_float(rr[0]) + __uint_as_float(rr[1]); }
    const float rs = rsqrtf(ss * (1.f / 128.f) + 1e-6f);
#pragma unroll
    for (int d0 = 0; d0 < 8; ++d0) { const f32x8 gv = *reinterpret_cast<const f32x8*>(gq + d0 * 16 + hi * 8);
#pragma unroll
      for (int e = 0; e < 8; ++e) qf[d0][e] *= rs * gv[e]; }
    const int tq = tq0 + wid * QBLK + r32;
#pragma unroll
    for (int h = 0; h < 2; ++h) { const float posf = (float)(h ? (tq & 63) : (tq >> 6));
#pragma unroll
      for (int dl = 0; dl < 2; ++dl)
#pragma unroll
        for (int e = 0; e < 8; ++e) { const float freq = exp2f(-(float)(dl * 16 + hi * 8 + e) * (13.287712379549449f / 32.f)); const float ang = posf * freq;
          double rev = (double)ang * 0.15915494309189535; rev -= floor(rev); const float fr = (float)rev; const float sn = __builtin_amdgcn_sinf(fr), cs = __builtin_amdgcn_cosf(fr);
          const float x1 = qf[4 * h + dl][e], x2 = qf[4 * h + dl + 2][e]; qf[4 * h + dl][e] = x1 * cs - x2 * sn; qf[4 * h + dl + 2][e] = x2 * cs + x1 * sn; } }
#pragma unroll
    for (int d0 = 0; d0 < 8; ++d0) { u32x4 w = {cvtpk(qf[d0][0], qf[d0][1]), cvtpk(qf[d0][2], qf[d0][3]), cvtpk(qf[d0][4], qf[d0][5]), cvtpk(qf[d0][6], qf[d0][7])}; qr[d0] = *reinterpret_cast<bf16x8*>(&w); } }
  unsigned koff[2], voff[2];
#pragma unroll
  for (int q = 0; q < 2; ++q) { const int P = wid * 2 + q;
    { const int row = 4 * P + (lane >> 4), c = (lane & 15) ^ (row & 7); koff[q] = (unsigned)(row * LDK + c * 8) * 2u; }
    { const int sI = 2 * P + (lane >> 5), ch = lane & 31, kk = (sI >> 2) * 8 + (ch >> 2), cc = (sI & 3) * 32 + (ch & 3) * 8, k = (kk & ~0xC) | ((kk & 4) << 1) | ((kk & 8) >> 1); voff[q] = (unsigned)(k * LDK + cc) * 2u; } }
  const int pbase = wid * 2048;
  const int NT = seq / KVBLK; const size_t tstep = (size_t)KVBLK * LDK * 2;
#define DMA_K(t, slot) do { const char* g_ = (const char*)Kh + (size_t)(t) * tstep; DMA16(g_ + koff[0], DMA_K0 + (slot) * (int)SHM_K + pbase); DMA16(g_ + koff[1], DMA_K0 + (slot) * (int)SHM_K + pbase + 1024); } while (0)
#define DMA_V(t, slot) do { const char* g_ = (const char*)Vh + (size_t)(t) * tstep; DMA16(g_ + voff[0], DMA_V0 + (slot) * (int)SHM_V + pbase); DMA16(g_ + voff[1], DMA_V0 + (slot) * (int)SHM_V + pbase + 1024); } while (0)
#define HALF_END() do { SBAR(); asm volatile("s_waitcnt vmcnt(4) lgkmcnt(0)" ::: "memory"); __builtin_amdgcn_s_barrier(); asm volatile("" ::: "memory"); SBAR(); } while (0)
#define RESC(a) do { if (__any((a) < 1.f)) { if (hi == 0) al_l[r32] = (a); asm volatile("s_waitcnt lgkmcnt(0)" ::: "memory"); \
    for (int d = 0; d < 4; ++d) for (int r = 0; r < 16; ++r) o[d][r] *= al_l[crow(r, hi)]; } } while (0)
#define KPTR(slot) ((const bf16*)(lds + DMA_K0 + (slot) * (int)SHM_K))
  const int vb0 = (int)(uintptr_t)(lds + DMA_V0) + v_rd_base(lane);
  int kb[4];
#pragma unroll
  for (int k = 0; k < 4; ++k) kb[k] = (int)(uintptr_t)(lds + DMA_K0) + r32 * 256 + ((k * 32 + hi * 16) ^ ((r32 & 7) << 4));
#define QKT(slot, ...) do { const int so_ = (slot) * (int)SHM_K; const int ka_[4] = {kb[0] + so_, kb[1] + so_, kb[2] + so_, kb[3] + so_}; KFr f_; qkt_p_begin(f_, ka_); __VA_ARGS__; qkt_p_rest(f_, p0, p1, ka_, qr); } while (0)
  f32x16 p0, p1; float mn, al = 1.f; bf16x8 pa0, pa1, pa2, pa3;
  lds_cf tbl = (lds_cf)(__attribute__((address_space(3))) char*)(lds + PP_TBL);
  const int nb_tq = tq0 + wid * QBLK + r32, nb_rq = nb_tq >> 6, nb_cq = nb_tq & 63;
  int nb_r0w = __builtin_amdgcn_readfirstlane((tq0 + wid * QBLK) >> 6) - 4; nb_r0w = nb_r0w < 0 ? 0 : (nb_r0w > 248 ? 248 : nb_r0w);
#define ACT(t) (!NB || (unsigned)(krow0 + (t) - nb_r0w) < 8u)
  DMA_K(0, 0); DMA_V(0, 0); DMA_K(1, 1);
  asm volatile("s_waitcnt vmcnt(2)" ::: "memory"); __builtin_amdgcn_s_barrier(); asm volatile("" ::: "memory"); SBAR();
  if (wid >= 4) { __builtin_amdgcn_s_barrier(); asm volatile("" ::: "memory"); SBAR(); }
  SBAR(); if (ACT(0)) QKT(0, do { DMA_K(2, 2); DMA_V(1, 1); } while (0)); else { DMA_K(2, 2); DMA_V(1, 1); }
  HALF_END();
  if (ACT(0)) { if constexpr (NB) nbmask(p0, p1, krow0, nb_rq, nb_cq, hi, tbl); partialSM(p0, p1, m_reg, mn, al); finishSM(p0, p1, al, l_reg, pa0, pa1, pa2, pa3); }
  HALF_END();
  int s0 = 1, s1 = 2, s2 = 0;
  for (int j = 1; j < NT; ++j) {
    SBAR();
    if (ACT(j)) QKT(s0, do { const int tk = j + 2 < NT ? j + 2 : NT - 1, tv = j + 1 < NT ? j + 1 : NT - 1; DMA_K(tk, s2); DMA_V(tv, s1); } while (0));
    else { const int tk = j + 2 < NT ? j + 2 : NT - 1, tv = j + 1 < NT ? j + 1 : NT - 1; DMA_K(tk, s2); DMA_V(tv, s1); }
    if (ACT(j - 1)) pv_ks(o, vb0 + s2 * (int)SHM_V, pa0, pa1, pa2, pa3);
    HALF_END();
    if (ACT(j)) { if constexpr (NB) nbmask(p0, p1, krow0 + j, nb_rq, nb_cq, hi, tbl);
      partialSM(p0, p1, m_reg, mn, al); RESC(al);
      finishSM(p0, p1, al, l_reg, pa0, pa1, pa2, pa3); }
    HALF_END();
    { const int t_ = s0; s0 = s1; s1 = s2; s2 = t_; }
  }
  asm volatile("s_waitcnt vmcnt(0)" ::: "memory");
  if (ACT(NT - 1)) pv_ks(o, vb0 + s2 * (int)SHM_V, pa0, pa1, pa2, pa3);
  if (wid < 4) { SBAR(); asm volatile("s_waitcnt lgkmcnt(0)" ::: "memory"); __builtin_amdgcn_s_barrier(); asm volatile("" ::: "memory"); SBAR(); }
  SBAR(); asm volatile("s_waitcnt lgkmcnt(0)" ::: "memory"); __builtin_amdgcn_s_barrier(); asm volatile("" ::: "memory"); SBAR();
  if (hi == 0) li_l[r32] = l_reg; asm volatile("s_waitcnt lgkmcnt(0)" ::: "memory");
  float rli[16];
#pragma unroll
  for (int r = 0; r < 16; ++r) rli[r] = __builtin_amdgcn_rcpf(li_l[crow(r, hi)]);
  bf16* Ow = Ob + (long)(wid * QBLK) * LDO;
  store_o_staged(o, rli, Ow, lds + wid * 8192, lane);
  asm volatile("s_waitcnt vmcnt(0) lgkmcnt(0)" ::: "memory"); __builtin_amdgcn_s_barrier(); asm volatile("" ::: "memory");
#undef DMA_K
#undef DMA_V
#undef HALF_END
#undef RESC
#undef KPTR
#undef QKT
#undef ACT
}
#undef DMA16

#undef KSWZ
}
#ifndef MK_N_LAUNCHES
#define MK_N_LAUNCHES 1
#endif
constexpr int NWAVES = 8, NTHR = NWAVES * 64;
constexpr int S = 16384, DM = 2048, INW = 4608, DFF = 8192, PLE = 256, NPH = 11;
constexpr float EPS = 1e-6f;
typedef unsigned short bf16r;
typedef float f32x4 __attribute__((ext_vector_type(4)));
typedef unsigned v4u __attribute__((ext_vector_type(4)));
typedef unsigned v2u __attribute__((ext_vector_type(2)));
#define LAS __attribute__((address_space(3)))
#define GAS __attribute__((address_space(1)))
constexpr size_t MiB = 1u << 20;
constexpr size_t WS_WIN = 1 * MiB, WS_WO = 19 * MiB, WS_WUP = 27 * MiB, WS_WDN = 59 * MiB, WS_WG = 91 * MiB, WS_WP = 99 * MiB;
constexpr size_t WS_PBF = 100 * MiB;
constexpr size_t WS_A = 108 * MiB;
constexpr size_t WS_B = 364 * MiB;
constexpr size_t WS_END = 492 * MiB;
constexpr int LDS_BYTES = 147456; constexpr int MISC_OFF = 131072 + 320;
constexpr size_t WS_RS0 = 65536, WS_RS2 = 131072, WS_RS3 = 196608;
constexpr size_t WS_CTL = 0, CTL_ZERO_BYTES = 16384;

__device__ __forceinline__ unsigned f2bf(float f) { unsigned u = __builtin_bit_cast(unsigned, f); return (u + 0x7fffu + ((u >> 16) & 1u)) >> 16; }
__device__ __forceinline__ unsigned pk2(float lo, float hi) { return f2bf(lo) | (f2bf(hi) << 16); }
__device__ __forceinline__ float bf2f(unsigned short b) { return __builtin_bit_cast(float, (unsigned)b << 16); }
__device__ __forceinline__ float wave_sum(float v) {
#pragma unroll
    for (int o = 1; o < 64; o <<= 1) v += __shfl_xor(v, o);
    return v;
}
__device__ __forceinline__ void p0_transpose_item(const float* __restrict__ W, int K, int N, bf16r* __restrict__ WT, LAS float* scr, int item, int lane, const float* __restrict__ gk = nullptr) {
    const int nblk = N / 32, kb = item / nblk, nb = item % nblk, k0 = 64 * kb, n0 = 32 * nb;
    const float gv = gk ? gk[k0 + lane] : 1.f;
#pragma unroll
    for (int i = 0; i < 32; ++i) { const int kk = 2 * i + (lane >> 5); const float g_lo = __builtin_bit_cast(float, __builtin_amdgcn_readlane(__builtin_bit_cast(int, gv), 2 * i)), g_hi = __builtin_bit_cast(float, __builtin_amdgcn_readlane(__builtin_bit_cast(int, gv), 2 * i + 1)); const float gsel = (lane >> 5) ? g_hi : g_lo;
        scr[kk * 33 + (lane & 31)] = W[(size_t)(k0 + kk) * N + n0 + (lane & 31)] * gsel; }
    asm volatile("s_waitcnt lgkmcnt(0)" ::: "memory");
    const int c = lane & 7;
#pragma unroll
    for (int j = 0; j < 4; ++j) { const int n = (lane >> 3) + 8 * j; const LAS float* s = scr + (8 * c) * 33 + n;
        v4u o; o.x = pk2(s[0 * 33], s[1 * 33]); o.y = pk2(s[2 * 33], s[3 * 33]); o.z = pk2(s[4 * 33], s[5 * 33]); o.w = pk2(s[6 * 33], s[7 * 33]);
        *(v4u*)(WT + (size_t)(n0 + n) * K + k0 + 8 * c) = o; }
    asm volatile("s_waitcnt lgkmcnt(0)" ::: "memory");
}
__device__ __forceinline__ void row_norm_bf16(const float* __restrict__ xrow, bf16r* __restrict__ orow, float* __restrict__ rsout, int lane) {
    const f32x4* xr = (const f32x4*)xrow + lane;
    f32x4 v[8]; float s = 0.f;
#pragma unroll
    for (int j = 0; j < 8; ++j) { v[j] = xr[64 * j]; s += (v[j].x * v[j].x + v[j].y * v[j].y) + (v[j].z * v[j].z + v[j].w * v[j].w); }
    const float rs = rsqrtf(wave_sum(s) * (1.f / DM) + EPS);
    if (lane == 0) *rsout = rs;
    v2u* o8 = (v2u*)orow + lane;
#pragma unroll
    for (int j = 0; j < 8; ++j) { v2u w; w.x = pk2(v[j].x, v[j].y); w.y = pk2(v[j].z, v[j].w); o8[64 * j] = w; }
}
template <int XN  , bool RB, bool HB>
__device__ __forceinline__ void row_res_norm(const void* res, const bf16r* __restrict__ trow, const float* __restrict__ gpost, const float* __restrict__ gpre,
                                             void* hout, bf16r* __restrict__ xnout, int lane, float* __restrict__ rsout = nullptr, const bf16r* __restrict__ glog = nullptr  ) {
    const v4u* tr = (const v4u*)trow + lane; const f32x4* gp = (const f32x4*)gpost + 2 * lane;
    float t[4][8]; f32x4 h[4][2]; float s = 0.f;
#pragma unroll
    for (int j = 0; j < 4; ++j) { const v4u raw = tr[64 * j];
        if constexpr (RB) { const v4u rw = ((const v4u*)res + lane)[64 * j];
            h[j][0] = (f32x4){__builtin_bit_cast(float, rw.x << 16), __builtin_bit_cast(float, rw.x & 0xffff0000u), __builtin_bit_cast(float, rw.y << 16), __builtin_bit_cast(float, rw.y & 0xffff0000u)};
            h[j][1] = (f32x4){__builtin_bit_cast(float, rw.z << 16), __builtin_bit_cast(float, rw.z & 0xffff0000u), __builtin_bit_cast(float, rw.w << 16), __builtin_bit_cast(float, rw.w & 0xffff0000u)}; }
        else { const f32x4* rr = (const f32x4*)res + 2 * lane; h[j][0] = rr[128 * j]; h[j][1] = rr[128 * j + 1]; }
#pragma unroll
        for (int e = 0; e < 4; ++e) { t[j][2 * e] = __builtin_bit_cast(float, raw[e] << 16); t[j][2 * e + 1] = __builtin_bit_cast(float, raw[e] & 0xffff0000u); }
        if (glog) { const v4u gr_ = ((const v4u*)glog + lane)[64 * j];
#pragma unroll
            for (int e = 0; e < 4; ++e) { t[j][2 * e] *= __builtin_amdgcn_rcpf(1.f + __expf(-__builtin_bit_cast(float, gr_[e] << 16))); t[j][2 * e + 1] *= __builtin_amdgcn_rcpf(1.f + __expf(-__builtin_bit_cast(float, gr_[e] & 0xffff0000u))); } }
#pragma unroll
        for (int e = 0; e < 8; ++e) s += t[j][e] * t[j][e]; }
    const float rs = rsqrtf(wave_sum(s) * (1.f / DM) + EPS);
    float s2 = 0.f;
#pragma unroll
    for (int j = 0; j < 4; ++j) {
#pragma unroll
        for (int q = 0; q < 2; ++q) { const f32x4 gj = gp[128 * j + q]; const f32x4 tv = {t[j][4 * q], t[j][4 * q + 1], t[j][4 * q + 2], t[j][4 * q + 3]};
            h[j][q] = h[j][q] + tv * rs * gj;
            if constexpr (!HB) ((f32x4*)hout + 2 * lane)[128 * j + q] = h[j][q];
            s2 += (h[j][q].x * h[j][q].x + h[j][q].y * h[j][q].y) + (h[j][q].z * h[j][q].z + h[j][q].w * h[j][q].w); }
        if constexpr (HB) { v4u w; w.x = pk2(h[j][0].x, h[j][0].y); w.y = pk2(h[j][0].z, h[j][0].w); w.z = pk2(h[j][1].x, h[j][1].y); w.w = pk2(h[j][1].z, h[j][1].w); ((v4u*)hout + lane)[64 * j] = w; } }
    if constexpr (XN == 2) { const float rs2 = rsqrtf(wave_sum(s2) * (1.f / DM) + EPS); if (lane == 0) *rsout = rs2; }
    if constexpr (XN == 1) {
        const float rs2 = rsqrtf(wave_sum(s2) * (1.f / DM) + EPS);
        const f32x4* gq = (const f32x4*)gpre + 2 * lane; v4u* o16 = (v4u*)xnout + lane;
#pragma unroll
        for (int j = 0; j < 4; ++j) { const f32x4 g0 = gq[128 * j], g1 = gq[128 * j + 1]; v4u w;
            w.x = pk2(h[j][0].x * rs2 * g0.x, h[j][0].y * rs2 * g0.y); w.y = pk2(h[j][0].z * rs2 * g0.z, h[j][0].w * rs2 * g0.w);
            w.z = pk2(h[j][1].x * rs2 * g1.x, h[j][1].y * rs2 * g1.y); w.w = pk2(h[j][1].z * rs2 * g1.z, h[j][1].w * rs2 * g1.w); o16[64 * j] = w; }
    }
}

#define XB_TMO      128
#define XB_XCNT(j)  (256  + 64 * (j))
#define XB_XSUB(j)  (1280 + 64 * (j))
#define XB_XGEN(j)  (2304 + 64 * (j))
#define XB_TOP      3328
#define XB_TOPGEN   3392
#define XCD_BAR_WORDS 3456
#define XB_SPIN_CAP (1u << 18)

__device__ __forceinline__ unsigned xb_ld(unsigned* p)              { return __hip_atomic_load(p, __ATOMIC_RELAXED, __HIP_MEMORY_SCOPE_AGENT); }
__device__ __forceinline__ unsigned xb_add(unsigned* p, unsigned v) { return __hip_atomic_fetch_add(p, v, __ATOMIC_RELAXED, __HIP_MEMORY_SCOPE_AGENT); }
__device__ __forceinline__ unsigned xb_xcc_id() { return (unsigned)__builtin_amdgcn_s_getreg((3 << 11) | 20) & 0xFu; }
#define XB_SPIN(cond, bar) do { unsigned _sp = 0; while (cond) { __builtin_amdgcn_s_sleep(1); \
    if ((++_sp & 255u) == 0u) { if (xb_ld(&(bar)[XB_TMO])) break; if (_sp > XB_SPIN_CAP) { atomicAdd(&(bar)[XB_TMO], 1u); break; } } } } while (0)

struct XcdBarrier {
    bool t0;
    unsigned* bar; unsigned x;
    volatile LAS unsigned* st;
};

__device__ __forceinline__ XcdBarrier xcd_barrier_post(unsigned* bar, volatile LAS unsigned* st) {
    XcdBarrier b; b.t0 = threadIdx.x == 0; b.bar = bar; b.x = xb_xcc_id(); b.st = st;
    if (threadIdx.x == 0) (void)xb_add(&bar[XB_XCNT(b.x)], 1u);
    return b;
}
__device__ __forceinline__ void xcd_barrier_complete(unsigned* bar, unsigned x, unsigned& nloc, unsigned& nx) {
    const unsigned G = gridDim.x * gridDim.y * gridDim.z;
    unsigned sum, cnt, mine, sp = 0u;
    for (;;) {
        sum = 0u; cnt = 0u; mine = 0u;
#pragma unroll
        for (unsigned j = 0; j < 16; ++j) { const unsigned c = xb_ld(&bar[XB_XCNT(j)]); sum += c; cnt += (c > 0u) ? 1u : 0u; mine = (j == x) ? c : mine; }
        if (sum == G) break;
        __builtin_amdgcn_s_sleep(1);
        if ((++sp & 255u) == 0u) { if (xb_ld(&bar[XB_TMO])) break; if (sp > XB_SPIN_CAP) { atomicAdd(&bar[XB_TMO], 1u); break; } }
    }
    nloc = mine > 0u ? mine : 1u; nx = cnt > 0u ? cnt : 1u;
}

__device__ __forceinline__ void xcd_barrier(const XcdBarrier& b) {
    asm volatile("s_waitcnt vmcnt(0)" ::: "memory");
    __syncthreads();
    if (b.t0) {
        unsigned* bar = b.bar;
        __builtin_amdgcn_s_waitcnt(0);
        unsigned nloc = b.st[0], nx = b.st[1];
        if (nloc == 0u) { xcd_barrier_complete(bar, b.x, nloc, nx); b.st[0] = nloc; b.st[1] = nx; }
        const unsigned old = xb_add(&bar[XB_XSUB(b.x)], 1u);
        const unsigned gen = old / nloc;
        if (old + 1u == (gen + 1u) * nloc) {
            __builtin_amdgcn_fence(__ATOMIC_RELEASE, "agent");
            asm volatile("s_waitcnt vmcnt(0)" ::: "memory");
            const unsigned og = xb_add(&bar[XB_TOP], 1u);
            const unsigned tg = og / nx;
            if (og + 1u == (tg + 1u) * nx) xb_add(&bar[XB_TOPGEN], 1u);
            else XB_SPIN(xb_ld(&bar[XB_TOPGEN]) == tg, bar);
            __builtin_amdgcn_fence(__ATOMIC_ACQUIRE, "agent");
            xb_add(&bar[XB_XGEN(b.x)], 1u);
            asm volatile("s_waitcnt vmcnt(0)" ::: "memory");
        } else {
            XB_SPIN(xb_ld(&bar[XB_XGEN(b.x)]) == gen, bar);
            __builtin_amdgcn_fence(__ATOMIC_ACQUIRE, "agent");
            asm volatile("s_waitcnt vmcnt(0)" ::: "memory");
        }
    }
    __syncthreads();
}
#define A_X        (args.in[0])
#define A_P        (args.in[1])
#define A_GPREMIX  (args.in[2])
#define A_WIN      (args.in[3])
#define A_GQ       (args.in[4])
#define A_GK       (args.in[5])
#define A_RPB      (args.in[6])
#define A_WO       (args.in[7])
#define A_GPOSTMIX (args.in[8])
#define A_GPREMLP  (args.in[9])
#define A_WUP      (args.in[10])
#define A_WDN      (args.in[11])
#define A_GPOSTMLP (args.in[12])
#define A_GPREPLE  (args.in[13])
#define A_WGATE    (args.in[14])
#define A_WPLE     (args.in[15])
#define A_GPOSTPLE (args.in[16])
#define W_(off)    (args.ws + (off))
struct Args { const float* in[17]; float* out; unsigned char* ws; int ph_lo, ph_hi; };

__global__ void __launch_bounds__(NTHR, 2) mega_fwd(Args args) {
    extern __shared__ __attribute__((aligned(16))) unsigned char lds[];
    const int G = gridDim.x, bx = blockIdx.x, NGW = G * NWAVES;
    const int wave_s = __builtin_amdgcn_readfirstlane((int)threadIdx.x >> 6);
#define LANEVARS int lane_ = __builtin_amdgcn_mbcnt_hi(~0u, __builtin_amdgcn_mbcnt_lo(~0u, 0u)); asm volatile("" : "+v"(lane_)); const int lane = lane_, wave = wave_s, tid = wave * 64 + lane, gw = bx * NWAVES + wave; (void)lane; (void)gw; (void)tid;
    const int lo = args.ph_lo, hi = args.ph_hi;
#ifdef ONLY_PHASE
#define IN(k) ((k) == ONLY_PHASE && lo <= (k) && (k) < hi)
#else
#define IN(k) (lo <= (k) && (k) < hi)
#endif
#ifdef PROBE_K
#define STAMP(k) do { if (bx == 0 && wave_s == 0 && __builtin_amdgcn_mbcnt_hi(~0u, __builtin_amdgcn_mbcnt_lo(~0u, 0u)) == 0) ((volatile LAS unsigned*)((LAS unsigned char*)lds + MISC_OFF))[16 + (k)] = (unsigned)__builtin_amdgcn_s_memrealtime(); } while (0)
#else
#define STAMP(k) do { } while (0)
#endif
#define SEAM(k) do { if (IN(k) && IN((k) + 1)) { { XcdBarrier xb_; xb_.t0 = (wave_s == 0) && (__builtin_amdgcn_mbcnt_hi(~0u, __builtin_amdgcn_mbcnt_lo(~0u, 0u)) == 0); xb_.bar = (unsigned*)args.ws; xb_.x = xb_xcc_id(); xb_.st = (volatile LAS unsigned*)((LAS unsigned char*)lds + MISC_OFF) + 8; xcd_barrier(xb_); } } } while (0)
    LAS unsigned char* ldsl = (LAS unsigned char*)lds;
    if (args.out == nullptr) cg::this_grid().sync();
    if (hi - lo > 1) {
        for (int u = threadIdx.x; u < (LDS_BYTES - 131072) / 4; u += NTHR) ((LAS unsigned*)(ldsl + 131072))[u] = 0u;
        __syncthreads();
        (void)xcd_barrier_post((unsigned*)args.ws, (volatile LAS unsigned*)(ldsl + MISC_OFF) + 8);
    }

    STAMP(0);
    if (IN(0)) {
        LANEVARS
        LAS float* scr = (LAS float*)(ldsl + wave * 16384);
        constexpr int I_IN = (DM / 64) * (INW / 32), I_O = (DM / 64) * (DM / 32), I_UP = (DM / 64) * (DFF / 32), I_DN = (DFF / 64) * (DM / 32), I_G = I_O, I_P = (PLE / 64) * (DM / 32);
        constexpr int NITEMS = I_IN + I_O + I_UP + I_DN + I_G + I_P;
        for (int it = gw; it < NITEMS; it += NGW) {
            int r = it;
            if (r < I_IN) { p0_transpose_item(A_WIN, DM, INW, (bf16r*)W_(WS_WIN), scr, r, lane, A_GPREMIX); continue; } r -= I_IN;
            if (r < I_O) { p0_transpose_item(A_WO, DM, DM, (bf16r*)W_(WS_WO), scr, r, lane); continue; } r -= I_O;
            if (r < I_UP) { p0_transpose_item(A_WUP, DM, DFF, (bf16r*)W_(WS_WUP), scr, r, lane, A_GPREMLP); continue; } r -= I_UP;
            if (r < I_DN) { p0_transpose_item(A_WDN, DFF, DM, (bf16r*)W_(WS_WDN), scr, r, lane); continue; } r -= I_DN;
            if (r < I_G) { p0_transpose_item(A_WGATE, DM, DM, (bf16r*)W_(WS_WG), scr, r, lane, A_GPREPLE); continue; } r -= I_G;
            p0_transpose_item(A_WPLE, PLE, DM, (bf16r*)W_(WS_WP), scr, r, lane);
        }
        for (int m = gw; m < S; m += NGW) row_norm_bf16(A_X + (size_t)m * DM, (bf16r*)W_(WS_B) + (size_t)m * DM, (float*)W_(WS_RS0) + m, lane);
        for (size_t i = (size_t)bx * NTHR + tid; i < (size_t)S * PLE / 8; i += (size_t)G * NTHR) {
            const f32x4 a = ((const f32x4*)A_P)[2 * i], b = ((const f32x4*)A_P)[2 * i + 1];
            v4u o; o.x = pk2(a.x, a.y); o.y = pk2(a.z, a.w); o.z = pk2(b.x, b.y); o.w = pk2(b.z, b.w); ((v4u*)W_(WS_PBF))[i] = o; }
        __syncthreads();
    }
    SEAM(0); STAMP(1);
    if (IN(1)) {
        pg8::Gemm g{(const bf16r*)W_(WS_B), (const bf16r*)W_(WS_WIN), S, INW, DM}; pg8::StaticOrder So; So.init(S, INW, G, bx);
        pg8::EpiBf16<0, true> E{(bf16r*)W_(WS_A), INW, (const float*)W_(WS_RS0)};
        pg8::gemm_phase<pg8::EpiBf16<0, true>, pg8::StaticOrder, true, true>(ldsl, g, So, E, wave_s);
        const int nu = (S / 256) * (INW / 256), extra = nu % G;
        pg8::Gemm g2{(const bf16r*)W_(WS_PBF), (const bf16r*)W_(WS_WP), S, DM, PLE}; pg8::TailOrder To; To.init(S, DM, G, bx, extra);
        pg8::EpiBf16<0> E2{(bf16r*)W_(WS_B + 64 * MiB), DM};
        pg8::gemm_phase<pg8::EpiBf16<0>, pg8::TailOrder, true, true>(ldsl, g2, To, E2, wave_s);
    }
    SEAM(1); STAMP(2);
    if (IN(2)) {
        LANEVARS
        const int sh = lane >> 4, k = lane & 15, half = k >> 3, kk = k & 7; const bool is_x1 = kk < 4;
        float freq[8], gk[8];
#pragma unroll
        for (int e = 0; e < 8; ++e) { freq[e] = exp2f(-(float)(8 * (kk & 3) + e) * (13.287712379549449f / 32.f)); gk[e] = A_GK[8 * k + e]; }
        bf16r* PROJ = (bf16r*)W_(WS_A);
        const int hd = 8 + (sh & 1);
        int it = gw; v4u raw = {0u, 0u, 0u, 0u};
        if (it < S / 2) raw = *(const v4u*)(PROJ + (size_t)(2 * it + (sh >> 1)) * INW + hd * 128 + 8 * k);
        for (; it < S / 2; it += NGW) {
            const int t = 2 * it + (sh >> 1); const v4u cur = raw;
            { const int it2 = it + NGW; if (it2 < S / 2) raw = *(const v4u*)(PROJ + (size_t)(2 * it2 + (sh >> 1)) * INW + hd * 128 + 8 * k); }
            float xv[8]; float ss = 0.f;
#pragma unroll
            for (int e = 0; e < 4; ++e) { xv[2 * e] = __builtin_bit_cast(float, cur[e] << 16); xv[2 * e + 1] = __builtin_bit_cast(float, cur[e] & 0xffff0000u); }
#pragma unroll
            for (int e = 0; e < 8; ++e) ss += xv[e] * xv[e];
            ss += __shfl_xor(ss, 1); ss += __shfl_xor(ss, 2); ss += __shfl_xor(ss, 4); ss += __shfl_xor(ss, 8);
            const float rs = rsqrtf(ss * (1.f / 128.f) + EPS);
            const float posf = (float)(half ? (t & 63) : (t >> 6));
            float o[8];
#pragma unroll
            for (int e = 0; e < 8; ++e) {
                const float y = xv[e] * rs * gk[e]; const float py = __shfl_xor(y, 4);
                const float ang = posf * freq[e];
                double rev = (double)ang * 0.15915494309189535; rev -= floor(rev);
                const float fr = (float)rev; const float sn = __builtin_amdgcn_sinf(fr), cs = __builtin_amdgcn_cosf(fr);
                o[e] = is_x1 ? y * cs - py * sn : y * cs + py * sn;
            }
            { v4u w; w.x = pk2(o[0], o[1]); w.y = pk2(o[2], o[3]); w.z = pk2(o[4], o[5]); w.w = pk2(o[6], o[7]); *(v4u*)(PROJ + (size_t)t * INW + hd * 128 + 8 * k) = w; }
        }
    }
    SEAM(2); STAMP(3);
    if (IN(3)) {
        char* al = (char*)lds; const bf16r* PROJ = (const bf16r*)W_(WS_A); bf16r* ATT = (bf16r*)W_(WS_A + 144 * MiB); const float* rpb = A_RPB;
#ifndef ATT_NO_A
        for (int u = bx; u < 512; u += G) {
            const int h = u >> 6, qb = u & 63, kvh = h >> 2;
            const att::bf16* Q = (const att::bf16*)PROJ + (size_t)(qb * 256) * INW + h * 128;
            const att::bf16* K = (const att::bf16*)PROJ + 1024 + kvh * 128; const att::bf16* V = (const att::bf16*)PROJ + 1280 + kvh * 128;
            att::attn_dense_pp<false>(Q, K, V, (att::bf16*)ATT + (size_t)(qb * 256) * DM + h * 128, S, al, wave_s, A_GQ, qb * 256, 0);
        }
#endif
        STAMP(12);
#ifndef ATT_NO_B
        for (int u = bx; u < 512; u += G) {
            const int h = u >> 6, qb = u & 63, R = qb * 4, rs = R - 4 < 0 ? 0 : R - 4, re = R + 8 > 256 ? 256 : R + 8;
            LAS float* tbl = (LAS float*)(ldsl + att::PP_TBL);
            int l2_ = __builtin_amdgcn_mbcnt_hi(~0u, __builtin_amdgcn_mbcnt_lo(~0u, 0u)); asm volatile("" : "+v"(l2_));
            for (int i = wave_s * 64 + l2_; i < 15 * 128; i += NTHR) { const int dr = i >> 7, dc = (i & 127) - 48; tbl[i] = (dc >= 0 && dc < 31) ? rpb[h * 465 + dr * 31 + dc] * (1.f / att::SCALE) : 0.f; }
            __syncthreads();
            const att::bf16* Q = (const att::bf16*)PROJ + (size_t)(qb * 256) * INW + 1536 + h * 128;
            const att::bf16* K = (const att::bf16*)PROJ + (size_t)(rs * 64) * INW + 2560 + h * 128; const att::bf16* V = K + 1024;
            att::attn_dense_pp<true>(Q, K, V, (att::bf16*)ATT + (size_t)(qb * 256) * DM + 1024 + h * 128, (re - rs) * 64, al, wave_s, nullptr, qb * 256, rs);
        }
#endif
    }
    SEAM(3); STAMP(4);
    if (IN(4)) {
        pg8::Gemm g{(const bf16r*)W_(WS_A + 144 * MiB), (const bf16r*)W_(WS_WO), S, DM, DM}; pg8::StaticOrder So; So.init(S, DM, G, bx);
        pg8::EpiBf16<0> E{(bf16r*)W_(WS_A), DM};
        pg8::gemm_phase<pg8::EpiBf16<0>, pg8::StaticOrder, true, true>(ldsl, g, So, E, wave_s);
    }
    SEAM(4); STAMP(5);
    if (IN(5)) {
        LANEVARS
        for (int m = gw; m < S; m += NGW) row_res_norm<2, true, true>((const bf16r*)W_(WS_B) + (size_t)m * DM, (const bf16r*)W_(WS_A) + (size_t)m * DM, A_GPOSTMIX, nullptr, (bf16r*)args.out + (size_t)m * DM, nullptr, lane, (float*)W_(WS_RS2) + m);
    }
    SEAM(5); STAMP(6);
    if (IN(6)) {
        pg8::Gemm g{(const bf16r*)args.out, (const bf16r*)W_(WS_WUP), S, DFF, DM};   pg8::StaticOrder So; So.init(S, DFF, G, bx);
        pg8::EpiBf16<2, true> E{(bf16r*)W_(WS_A), DFF, (const float*)W_(WS_RS2)};
        pg8::gemm_phase<pg8::EpiBf16<2, true>, pg8::StaticOrder, true, true>(ldsl, g, So, E, wave_s);
    }
    SEAM(6); STAMP(7);
    if (IN(7)) {
        pg8::Gemm g{(const bf16r*)W_(WS_A), (const bf16r*)W_(WS_WDN), S, DM, DFF}; pg8::StaticOrder So; So.init(S, DM, G, bx);
        pg8::EpiBf16<0> E{(bf16r*)W_(WS_B), DM};
        pg8::gemm_phase<pg8::EpiBf16<0>, pg8::StaticOrder, true, true>(ldsl, g, So, E, wave_s);
    }
    SEAM(7); STAMP(8);
    if (IN(8)) {
        LANEVARS
        for (int m = gw; m < S; m += NGW) row_res_norm<2, true, true>((const bf16r*)args.out + (size_t)m * DM, (const bf16r*)W_(WS_B) + (size_t)m * DM, A_GPOSTMLP, nullptr, (bf16r*)W_(WS_A + 64 * MiB) + (size_t)m * DM, nullptr, lane, (float*)W_(WS_RS3) + m);
    }
    SEAM(8); STAMP(9);
    if (IN(9)) {
        pg8::Gemm g{(const bf16r*)W_(WS_A + 64 * MiB), (const bf16r*)W_(WS_WG), S, DM, DM};   pg8::StaticOrder So; So.init(S, DM, G, bx);
        pg8::EpiBf16<0, true> E{(bf16r*)W_(WS_A), DM, (const float*)W_(WS_RS3)};
        pg8::gemm_phase<pg8::EpiBf16<0, true>, pg8::StaticOrder, true, true>(ldsl, g, So, E, wave_s);
    }
    SEAM(9); STAMP(10);
    if (IN(10)) {
        LANEVARS
        for (int m = gw; m < S; m += NGW) row_res_norm<0, true, false>((const bf16r*)W_(WS_A + 64 * MiB) + (size_t)m * DM, (const bf16r*)W_(WS_B + 64 * MiB) + (size_t)m * DM, A_GPOSTPLE, nullptr, args.out + (size_t)m * DM, nullptr, lane, nullptr, (const bf16r*)W_(WS_A) + (size_t)m * DM);
    }
#ifdef PROBE_K
    __syncthreads(); STAMP(11); __syncthreads();
    if (bx == 0) {
        volatile LAS unsigned* st = (volatile LAS unsigned*)((LAS unsigned char*)lds + MISC_OFF) + 16;
        const float ta = (float)(st[PROBE_K + 1] - st[PROBE_K]) * 0.01f, tr = (float)(st[PROBE_R1] - st[PROBE_R]) * 0.01f;
        const float qa = floorf(ta / (float)PROBE_TA * 32.f + 0.5f) / 32.f, qr = floorf(tr / (float)PROBE_TR * 64.f + 0.5f) / 64.f;
        const int t = wave_s * 64 + __builtin_amdgcn_mbcnt_hi(~0u, __builtin_amdgcn_mbcnt_lo(~0u, 0u));
        if (t == 0) args.out[0] += 0.12f + 0.25f * qa;
        for (int i = t; i < (1 << 19); i += NTHR) args.out[2048 + i] += 0.1f * qr;
    }
#endif
#undef IN
#undef SEAM
}

extern "C" void kernel_launch(void* const* d_in, const int* in_sizes, int n_in, void* d_out, int out_size, void* d_ws, size_t ws_size, hipStream_t stream) {
    static int grid = 0;
    if (grid == 0) {
        if (n_in != 17 || in_sizes[0] != S * DM || out_size != S * DM || ws_size < WS_END) {
            fprintf(stderr, "kernel_launch: shape/workspace mismatch: n_in %d in0 %d out %d ws %zu (need %zu)\n", n_in, n_in > 0 ? in_sizes[0] : -1, out_size, ws_size, (size_t)WS_END); grid = -1; return; }
        int dev = 0, cus = 0, per_cu = 0;
        if (hipGetDevice(&dev) != hipSuccess || hipDeviceGetAttribute(&cus, hipDeviceAttributeMultiprocessorCount, dev) != hipSuccess) { grid = -1; return; }
        if (hipFuncSetAttribute((const void*)mega_fwd, hipFuncAttributeMaxDynamicSharedMemorySize, LDS_BYTES) != hipSuccess) { fprintf(stderr, "kernel_launch: hipFuncSetAttribute failed\n"); grid = -1; return; }
        if (hipOccupancyMaxActiveBlocksPerMultiprocessor(&per_cu, (const void*)mega_fwd, NTHR, LDS_BYTES) != hipSuccess || per_cu < 1) per_cu = 1;
        (void)hipGetLastError();
        grid = cus * (per_cu > 1 ? 1 : per_cu);
    }
    if (grid < 0) return;
    if (hipMemsetAsync((char*)d_ws + WS_CTL, 0, CTL_ZERO_BYTES, stream) != hipSuccess) { fprintf(stderr, "kernel_launch: memset failed\n"); return; }
    Args a{};
    for (int i = 0; i < 17; ++i) a.in[i] = (const float*)d_in[i];
    a.out = (float*)d_out; a.ws = (unsigned char*)d_ws;
    if (MK_N_LAUNCHES == 1) {
        a.ph_lo = 0; a.ph_hi = NPH; void* kargs[] = {&a};
        hipError_t e = hipLaunchCooperativeKernel((const void*)mega_fwd, dim3(grid), dim3(NTHR), kargs, LDS_BYTES, stream);
        if (e != hipSuccess) fprintf(stderr, "kernel_launch: cooperative launch failed: %s (grid %d)\n", hipGetErrorString(e), grid);
    } else {
        for (int k = 0; k < NPH; ++k) { a.ph_lo = k; a.ph_hi = k + 1; hipLaunchKernelGGL(mega_fwd, dim3(grid), dim3(NTHR), LDS_BYTES, stream, a); }
    }
}
```

```cpp
#include <hip/hip_runtime.h>
#include <hip/hip_bf16.h>
#include <hip/hip_cooperative_groups.h>
#include <cstdio>
#include <cstdint>
#include <cmath>
namespace cg = cooperative_groups;
namespace pg8 {
#define PG8_LAS __attribute__((address_space(3)))
typedef unsigned short bf16_t;
typedef short bf16x8 __attribute__((ext_vector_type(8)));
typedef float f32x4 __attribute__((ext_vector_type(4)));
typedef unsigned u32x4 __attribute__((ext_vector_type(4)));
constexpr int BM = 256, BK = 64, HALF = 128, HTB = HALF * BK * 2  , STAGE_BYTES = 8 * HTB, NXCD = 8, WGM = 4;

__host__ __device__ __forceinline__ int lds_byte(int r, int c) { const int st = (r >> 4) * 2 + (c >> 5), rr = r & 15, cc = c & 31, ob = rr * 64 + cc * 2; return st * 1024 + (ob ^ (((ob >> 9) & 1) << 5)); }
__host__ __device__ __forceinline__ void stage_rc(int b, int& R, int& C) { const int st = b / 1024, sb = b % 1024, swz = sb ^ (((sb >> 9) & 1) << 5); R = (st >> 1) * 16 + swz / 64; C = (st & 1) * 32 + (swz % 64) / 2; }
__host__ __device__ __forceinline__ int perm32(int rho) { const int n = rho >> 4, i = rho & 15; return 8 * (i >> 2) + 4 * n + (i & 3); }

struct Unit { int pm, pn; };
struct Gemm { const bf16_t* A; const bf16_t* Bt; int M, N, K; };

struct StaticOrder {
    int nM, nN, nwg, G, c;
    __host__ __device__ void init(int M, int N, int G_, int c_) { nM = M / BM; nN = N / BM; nwg = nM * nN; G = G_; c = c_; }
    __host__ __device__ bool next(int i, Unit& u) const {
        const long L = (long)i * G + c; if (L >= nwg) return false;
        int wgid = (int)L; { const int q = nwg / NXCD, r = nwg % NXCD, xcd = wgid % NXCD, off = wgid / NXCD; wgid = (xcd < r ? xcd * (q + 1) : r * (q + 1) + (xcd - r) * q) + off; }
        const int nig = WGM * nN, gid = wgid / nig, fm = gid * WGM, gsz = (nM - fm) < WGM ? (nM - fm) : WGM;
        u.pm = fm + ((wgid % nig) % gsz); u.pn = (wgid % nig) / gsz; return true;
    }
    __device__ __forceinline__ void a_ready(const Unit&) const {}
    __device__ __forceinline__ void done(const Unit&) const {}
};

struct TailOrder {
    int nN, nwg, Gt, c;
    __host__ __device__ void init(int M, int N, int G_, int c_, int skip) { nN = N / BM; nwg = (M / BM) * nN; Gt = G_ - skip; c = c_ - skip; }
    __host__ __device__ bool next(int i, Unit& u) const { if (c < 0) return false; const long L = (long)i * Gt + c; if (L >= nwg) return false; u.pm = (int)L / nN; u.pn = (int)L % nN; return true; }
    __device__ __forceinline__ void a_ready(const Unit&) const {}
    __device__ __forceinline__ void done(const Unit&) const {}
};
__device__ __forceinline__ unsigned cvt_pk_bf16(float lo, float hi) { unsigned r; asm volatile("v_cvt_pk_bf16_f32 %0, %1, %2" : "=v"(r) : "v"(lo), "v"(hi)); return r; }
template <int ACT  , bool RS = false  > struct EpiBf16 {
    static constexpr bool PERM = true, AFTER_DRAIN = false;
    bf16_t* O; int ldc; const float* rs;
    __device__ __forceinline__ void prefetch(float (&pv)[8], const Unit& u, int wr, int fr) const {
        if constexpr (RS) { const float* p0 = rs + u.pm * BM + wr * 64 + fr;
#pragma unroll
            for (int i = 0; i < 8; ++i) { const float* p = p0 + (i >> 2) * HALF + (i & 3) * 16; asm volatile("global_load_dword %0, %1, off" : "=v"(pv[i]) : "v"(p) : "memory"); } }
        else {
#pragma unroll
            for (int i = 0; i < 8; ++i) pv[i] = 1.f; }
    }
    __device__ __forceinline__ void operator()(const f32x4 (&acc)[2][2][4][2], const Unit& u, int wr, int wc, int fr, int fq, const float (&pv)[8]) const {
        const int row0 = u.pm * BM + wr * 64 + fr; const int col0 = u.pn * BM + wc * 32 + 8 * fq;
#pragma unroll
        for (int ai = 0; ai < 2; ++ai)
#pragma unroll
            for (int m = 0; m < 4; ++m) { bf16_t* rowp = O + (size_t)(row0 + ai * HALF + m * 16) * ldc + col0; const float sc = RS ? pv[ai * 4 + m] : 1.f;
#pragma unroll
                for (int bj = 0; bj < 2; ++bj) { f32x4 v0 = acc[ai][bj][m][0] * sc, v1 = acc[ai][bj][m][1] * sc;
                    if (ACT == 2) {
#pragma unroll
                        for (int e = 0; e < 4; ++e) { float a = fmaxf(v0[e], 0.f), b = fmaxf(v1[e], 0.f); v0[e] = a * a; v1[e] = b * b; } }
                    if (ACT == 3) { const u32x4 ev = *(const u32x4*)(rowp + bj * HALF);
#pragma unroll
                        for (int e = 0; e < 2; ++e) { v0[2 * e] = __builtin_bit_cast(float, ev[e] << 16) * __builtin_amdgcn_rcpf(1.f + __expf(-v0[2 * e])); v0[2 * e + 1] = __builtin_bit_cast(float, ev[e] & 0xffff0000u) * __builtin_amdgcn_rcpf(1.f + __expf(-v0[2 * e + 1]));
                            v1[2 * e] = __builtin_bit_cast(float, ev[2 + e] << 16) * __builtin_amdgcn_rcpf(1.f + __expf(-v1[2 * e])); v1[2 * e + 1] = __builtin_bit_cast(float, ev[2 + e] & 0xffff0000u) * __builtin_amdgcn_rcpf(1.f + __expf(-v1[2 * e + 1])); } }
                    u32x4 w; w.x = cvt_pk_bf16(v0[0], v0[1]); w.y = cvt_pk_bf16(v0[2], v0[3]); w.z = cvt_pk_bf16(v1[0], v1[1]); w.w = cvt_pk_bf16(v1[2], v1[3]);
                    *(u32x4*)(rowp + bj * HALF) = w; } }
    }
};


template <class Epi, class Sched, bool ALIGN_EPI = false, bool SP2 = false>
__device__ __forceinline__ void gemm_phase(PG8_LAS unsigned char* lds, const Gemm g, const Sched& S, const Epi& E, int wave_s) {
    int lane_ = __builtin_amdgcn_mbcnt_hi(~0u, __builtin_amdgcn_mbcnt_lo(~0u, 0u)); asm volatile("" : "+v"(lane_));
    const int tid = wave_s * 64 + lane_, wid = __builtin_amdgcn_readfirstlane(tid >> 6), lane = tid & 63, wr = wid >> 2, wc = wid & 3, fr = lane & 15, fq = lane >> 4;
    const int K = g.K, nt = K / BK;
    unsigned voffA[2], voffB[2];
#pragma unroll
    for (int i = 0; i < 2; ++i) { int R, C; stage_rc(tid * 16 + i * 8192, R, C); const int Rb = Epi::PERM ? ((R & ~31) + perm32(R & 31)) : R;
        voffA[i] = (unsigned)(R * K + C) * 2u; voffB[i] = (unsigned)(Rb * K + C) * 2u; }
    const size_t kstep = (size_t)(BK * 2);
    const size_t hstep = (size_t)HALF * K * 2;
    const size_t tstep = 2 * hstep;
    const unsigned ldsw = (unsigned)wid * 1024u;
    const int aoff = lds_byte(wr * 64 + fr, fq * 8), boff = lds_byte(wc * 32 + fr, fq * 8);
#define PG8_SA(b, h) (((b) * 2 + (h)) * HTB)
#define PG8_SB(b, h) ((4 + (b) * 2 + (h)) * HTB)
#define PG8_STAGE(bufoff, gbase, voff) do { _Pragma("unroll") for (int _i = 0; _i < 2; ++_i) \
        __builtin_amdgcn_global_load_lds((const unsigned*)((const char*)(gbase) + (voff)[_i]), (PG8_LAS unsigned*)(lds + (bufoff) + ldsw + _i * 8192), 16, 0, 0); } while (0)
#define PG8_LDA(dst, b, h) do { _Pragma("unroll") for (int m = 0; m < 4; ++m) _Pragma("unroll") for (int k = 0; k < 2; ++k) dst[m][k] = *(const PG8_LAS bf16x8*)(lds + PG8_SA(b, h) + aoff + m * 2048 + k * 1024); } while (0)
#define PG8_LDB(dst, b, h) do { _Pragma("unroll") for (int n = 0; n < 2; ++n) _Pragma("unroll") for (int k = 0; k < 2; ++k) dst[n][k] = *(const PG8_LAS bf16x8*)(lds + PG8_SB(b, h) + boff + n * 2048 + k * 1024); } while (0)
#define PG8_MMA(ai, bj, At, Bt) do { __builtin_amdgcn_s_setprio(1); _Pragma("unroll") for (int m = 0; m < 4; ++m) _Pragma("unroll") for (int n = 0; n < 2; ++n) _Pragma("unroll") for (int k = 0; k < 2; ++k) \
        acc[ai][bj][m][n] = __builtin_amdgcn_mfma_f32_16x16x32_bf16(Bt[n][k], At[m][k], acc[ai][bj][m][n], 0, 0, 0); __builtin_amdgcn_s_setprio(0); } while (0)
#define PG8_WAIT_V(n) asm volatile("s_waitcnt vmcnt(" #n ")" ::: "memory")
#define PG8_WAIT_L(n) asm volatile("s_waitcnt lgkmcnt(" #n ")" ::: "memory")
#define PG8_BAR __builtin_amdgcn_s_barrier()
#define PG8_SCHED __builtin_amdgcn_sched_barrier(0)
    Unit cur, nxt; int ui = 0;
    if (!S.next(0, cur)) return;
    float pv[8]; E.prefetch(pv, cur, wr, fr);
    f32x4 acc[2][2][4][2];
#pragma unroll
    for (int a = 0; a < 2; ++a)
#pragma unroll
        for (int b = 0; b < 2; ++b)
#pragma unroll
            for (int m = 0; m < 4; ++m)
#pragma unroll
                for (int n = 0; n < 2; ++n) acc[a][b][m][n] = (f32x4){0.f, 0.f, 0.f, 0.f};
    bf16x8 At[4][2], B0[2][2], B1[2][2];
    const char* cA = (const char*)g.A + (size_t)cur.pm * tstep; const char* cB = (const char*)g.Bt + (size_t)cur.pn * tstep;
    S.a_ready(cur);
    if constexpr (SP2) {
        PG8_STAGE(PG8_SB(0, 0), cB, voffB); PG8_STAGE(PG8_SB(0, 1), cB + hstep, voffB); PG8_STAGE(PG8_SA(0, 0), cA, voffA); PG8_STAGE(PG8_SA(0, 1), cA + hstep, voffA);
        if (wr == 1) PG8_BAR;
        PG8_WAIT_V(2); PG8_BAR;
        PG8_STAGE(PG8_SB(1, 0), cB + kstep, voffB); PG8_STAGE(PG8_SA(1, 0), cA + kstep, voffA); PG8_STAGE(PG8_SB(1, 1), cB + hstep + kstep, voffB);
        PG8_WAIT_V(6); PG8_BAR;
    } else {
        PG8_STAGE(PG8_SB(0, 0), cB, voffB); PG8_STAGE(PG8_SA(0, 0), cA, voffA); PG8_STAGE(PG8_SB(0, 1), cB + hstep, voffB); PG8_STAGE(PG8_SA(0, 1), cA + hstep, voffA);
        if (wr == 1) PG8_BAR;
        PG8_WAIT_V(4); PG8_BAR;
        PG8_STAGE(PG8_SB(1, 0), cB + kstep, voffB); PG8_STAGE(PG8_SA(1, 0), cA + kstep, voffA); PG8_STAGE(PG8_SB(1, 1), cB + hstep + kstep, voffB);
        PG8_WAIT_V(6); PG8_BAR;
    }
    for (;;) {
        const bool has_next = S.next(ui + 1, nxt);
        const char* nA = has_next ? (const char*)g.A + (size_t)nxt.pm * tstep : cA; const char* nB = has_next ? (const char*)g.Bt + (size_t)nxt.pn * tstep : cB;
        for (int t = 0; t < nt; t += 2) {
            const bool last = (t == nt - 2);
            const char* a1 = cA + (size_t)(t + 1) * kstep;
            const char* a2 = last ? nA : cA + (size_t)(t + 2) * kstep; const char* b2 = last ? nB : cB + (size_t)(t + 2) * kstep;
            const char* a3 = a2 + kstep; const char* b3 = b2 + kstep;
            if (last && has_next) S.a_ready(nxt);
            if constexpr (SP2) {
            PG8_LDB(B0, 0, 0); PG8_LDB(B1, 0, 1); PG8_SCHED; PG8_LDA(At, 0, 0); PG8_STAGE(PG8_SA(1, 1), a1 + hstep, voffA);
            PG8_WAIT_V(8); PG8_WAIT_L(0); PG8_BAR; PG8_MMA(0, 0, At, B0); PG8_MMA(0, 1, At, B1); PG8_BAR; PG8_SCHED;
            PG8_LDA(At, 0, 1); PG8_STAGE(PG8_SB(0, 0), b2, voffB); PG8_STAGE(PG8_SB(0, 1), b2 + hstep, voffB); PG8_STAGE(PG8_SA(0, 0), a2, voffA);
            PG8_WAIT_V(8); PG8_WAIT_L(0); PG8_BAR; PG8_MMA(1, 0, At, B0); PG8_MMA(1, 1, At, B1); PG8_BAR; PG8_SCHED;
            PG8_LDB(B0, 1, 0); PG8_LDB(B1, 1, 1); PG8_SCHED; PG8_LDA(At, 1, 0); PG8_STAGE(PG8_SA(0, 1), a2 + hstep, voffA);
            PG8_WAIT_V(8); PG8_WAIT_L(0); PG8_BAR; PG8_MMA(0, 0, At, B0); PG8_MMA(0, 1, At, B1); PG8_BAR; PG8_SCHED;
            PG8_LDA(At, 1, 1); PG8_STAGE(PG8_SB(1, 0), b3, voffB); PG8_STAGE(PG8_SB(1, 1), b3 + hstep, voffB); PG8_STAGE(PG8_SA(1, 0), a3, voffA);
            PG8_WAIT_V(8); PG8_WAIT_L(0); PG8_BAR; PG8_MMA(1, 0, At, B0); PG8_MMA(1, 1, At, B1); PG8_BAR; PG8_SCHED;
            } else {
            PG8_LDB(B0, 0, 0); PG8_SCHED; PG8_LDA(At, 0, 0); PG8_STAGE(PG8_SA(1, 1), a1 + hstep, voffA);
            PG8_WAIT_L(8); PG8_BAR; PG8_WAIT_L(0); PG8_MMA(0, 0, At, B0); PG8_BAR; PG8_SCHED;
            PG8_LDB(B1, 0, 1); PG8_STAGE(PG8_SB(0, 0), b2, voffB);
            PG8_BAR; PG8_WAIT_L(0); PG8_MMA(0, 1, At, B1); PG8_BAR;
            PG8_LDA(At, 0, 1); PG8_STAGE(PG8_SA(0, 0), a2, voffA);
            PG8_BAR; PG8_WAIT_L(0); PG8_MMA(1, 0, At, B0); PG8_BAR; PG8_SCHED;
            PG8_STAGE(PG8_SB(0, 1), b2 + hstep, voffB);
            PG8_WAIT_V(6); PG8_BAR; PG8_MMA(1, 1, At, B1); PG8_BAR;
            PG8_LDB(B0, 1, 0); PG8_SCHED; PG8_LDA(At, 1, 0); PG8_STAGE(PG8_SA(0, 1), a2 + hstep, voffA);
            PG8_WAIT_L(8); PG8_BAR; PG8_WAIT_L(0); PG8_MMA(0, 0, At, B0); PG8_BAR; PG8_SCHED;
            PG8_LDB(B1, 1, 1); PG8_STAGE(PG8_SB(1, 0), b3, voffB);
            PG8_BAR; PG8_WAIT_L(0); PG8_MMA(0, 1, At, B1); PG8_BAR;
            PG8_LDA(At, 1, 1); PG8_STAGE(PG8_SA(1, 0), a3, voffA);
            PG8_BAR; PG8_WAIT_L(0); PG8_MMA(1, 0, At, B0); PG8_BAR; PG8_SCHED;
            PG8_STAGE(PG8_SB(1, 1), b3 + hstep, voffB);
            PG8_WAIT_V(6); PG8_BAR; PG8_MMA(1, 1, At, B1); PG8_BAR;
            }
        }
        if constexpr (ALIGN_EPI) { if (wr == 0) PG8_BAR; }
        if constexpr (!Epi::AFTER_DRAIN) { E(acc, cur, wr, wc, fr, fq, pv); S.done(cur); }
        if (!has_next) break;
#pragma unroll
        for (int a = 0; a < 2; ++a)
#pragma unroll
            for (int b = 0; b < 2; ++b)
#pragma unroll
                for (int m = 0; m < 4; ++m)
#pragma unroll
                    for (int n = 0; n < 2; ++n) acc[a][b][m][n] = (f32x4){0.f, 0.f, 0.f, 0.f};
        cur = nxt; cA = nA; cB = nB; ++ui;
        E.prefetch(pv, cur, wr, fr);
        if constexpr (ALIGN_EPI) { if (wr == 1) PG8_BAR; }
    }
    PG8_WAIT_V(0);
    if constexpr (!ALIGN_EPI) { if (wr == 0) PG8_BAR; }
    PG8_BAR;

#undef PG8_SA
#undef PG8_SB
#undef PG8_STAGE
#undef PG8_LDA
#undef PG8_LDB
#undef PG8_MMA
#undef PG8_WAIT_V
#undef PG8_WAIT_L
#undef PG8_BAR
#undef PG8_SCHED
}
}
namespace att {
using bf16 = __hip_bfloat16;
constexpr int   D = 128, NW = 8, QBLK = 32, KVBLK = 64;
constexpr float SCALE = 0.088388347648318440f;
constexpr float THR = 8.f;
#ifndef ATT_A_SDEPTH
#define ATT_A_SDEPTH 1
#endif
constexpr int SDEPTH = 2;
constexpr int LDQ = 4608, LDK = 4608, LDO = 2048;
constexpr size_t SHM_V = KVBLK * D * 2, SHM_K = KVBLK * D * 2, SHM_ATTN = 2 * SHM_V + 2 * SHM_K + NW * 64 * 4;
using bf16x8 = __attribute__((ext_vector_type(8))) short;
using s16x4  = __attribute__((ext_vector_type(4))) short;
using f32x16 = __attribute__((ext_vector_type(16))) float;
using f32x8  = __attribute__((ext_vector_type(8))) float;
using u32x4  = __attribute__((ext_vector_type(4))) unsigned;
#define KSWZ(row, colB) ((row) * 256 + ((colB) ^ (((row) & 7) << 4)))
#define SBAR() __builtin_amdgcn_sched_barrier(0)
__device__ __forceinline__ int crow(int r, int hi) { return (r & 3) + 8 * (r >> 2) + 4 * hi; }
__device__ __forceinline__ unsigned cvtpk(float lo, float hi) {
  unsigned r; asm volatile("v_cvt_pk_bf16_f32 %0, %1, %2" : "=v"(r) : "v"(lo), "v"(hi)); return r;
}
template <typename TIn> struct Stage;
template <> struct Stage<bf16>  { using T = bf16x8;
  __device__ static __forceinline__ T ld8(const bf16* p) { return *reinterpret_cast<const bf16x8*>(p); }
  __device__ static __forceinline__ bf16x8 tobf(T x) { return x; } };
template <> struct Stage<float> { using T = f32x8;
  __device__ static __forceinline__ T ld8(const float* p) { return *reinterpret_cast<const f32x8*>(p); }
  __device__ static __forceinline__ bf16x8 tobf(T x) {
    u32x4 w = {cvtpk(x[0], x[1]), cvtpk(x[2], x[3]), cvtpk(x[4], x[5]), cvtpk(x[6], x[7])}; return *reinterpret_cast<bf16x8*>(&w); } };

__device__ __forceinline__ void partialSM(f32x16& p0, f32x16& p1, float& m_reg, float& mn, float& alpha) {
  constexpr float C = SCALE * 1.4426950408889634f;
  float pmax = p0[0]; for (int r = 1; r < 16; ++r) pmax = fmaxf(pmax, p0[r]); for (int r = 0; r < 16; ++r) pmax = fmaxf(pmax, p1[r]);
  { auto rr = __builtin_amdgcn_permlane32_swap(__float_as_uint(pmax), __float_as_uint(pmax), false, false);
    pmax = fmaxf(__uint_as_float(rr[0]), __uint_as_float(rr[1])); }
  if (__builtin_expect(__all(pmax - m_reg <= THR / SCALE), 1)) { mn = m_reg; alpha = 1.f; }
  else { mn = fmaxf(m_reg, pmax); alpha = __builtin_amdgcn_exp2f((m_reg - mn) * C); m_reg = mn; }
  float mnC = -mn * C;
  for (int r = 0; r < 16; ++r) p0[r] = fmaf(p0[r], C, mnC); for (int r = 0; r < 16; ++r) p1[r] = fmaf(p1[r], C, mnC);
  for (int r = 0; r < 16; ++r) p0[r] = __builtin_amdgcn_exp2f(p0[r]);
}
__device__ __forceinline__ void finishSM(f32x16& p0, f32x16& p1, float alpha, float& l_reg, bf16x8& pa0, bf16x8& pa1, bf16x8& pa2, bf16x8& pa3) {
  for (int r = 0; r < 16; ++r) p1[r] = __builtin_amdgcn_exp2f(p1[r]);
  float ps = 0; for (int r = 0; r < 16; ++r) ps += p0[r]; for (int r = 0; r < 16; ++r) ps += p1[r];
  { auto rr = __builtin_amdgcn_permlane32_swap(__float_as_uint(ps), __float_as_uint(ps), false, false);
    ps = __uint_as_float(rr[0]) + __uint_as_float(rr[1]); }
  l_reg = l_reg * alpha + ps;
#define PK4(P, BASE, OUT) do { unsigned a0 = cvtpk(P[BASE + 0], P[BASE + 1]), a1 = cvtpk(P[BASE + 2], P[BASE + 3]);   \
    unsigned b0 = cvtpk(P[BASE + 4], P[BASE + 5]), b1 = cvtpk(P[BASE + 6], P[BASE + 7]);                              \
    auto r0 = __builtin_amdgcn_permlane32_swap(a0, b0, false, false); auto r1 = __builtin_amdgcn_permlane32_swap(a1, b1, false, false); \
    u32x4 w = {r0[0], r1[0], r0[1], r1[1]}; OUT = *reinterpret_cast<bf16x8*>(&w); } while (0)
  PK4(p0, 0, pa0); PK4(p0, 8, pa1); PK4(p1, 0, pa2); PK4(p1, 8, pa3);
#undef PK4
}
__device__ __forceinline__ void qkt(f32x16& p0, f32x16& p1, const bf16* Ks, const bf16x8* qr, int r32, int hi) {
  p0 = f32x16{}; p1 = f32x16{};
  for (int d0 = 0; d0 < 8; ++d0) { int cb = (d0 * 16 + hi * 8) * 2;
    bf16x8 b0 = *reinterpret_cast<const bf16x8*>((const char*)Ks + KSWZ(r32, cb));
    bf16x8 b1 = *reinterpret_cast<const bf16x8*>((const char*)Ks + KSWZ(32 + r32, cb));
    p0 = __builtin_amdgcn_mfma_f32_32x32x16_bf16(b0, qr[d0], p0, 0, 0, 0);
    p1 = __builtin_amdgcn_mfma_f32_32x32x16_bf16(b1, qr[d0], p1, 0, 0, 0); }
}
__device__ __forceinline__ int v_st(int k, int c) { const int kk = (k & ~0xC) | ((k & 4) << 1) | ((k & 8) >> 1); return ((kk >> 3) * 4 + (c >> 5)) * 512 + ((kk & 7) * 32 + (c & 31)) * 2; }
__device__ __forceinline__ int v_rd_base(int lane) { return ((lane & 3) << 3) | (((lane >> 2) & 3) << 6) | (((lane >> 4) & 1) << 5) | (((lane >> 5) & 1) << 8); }
constexpr int v_rd_off(int d0, int ks, int half) { return d0 * 512 + ks * 4096 + half * 2048; }
template <int OFF> __device__ __forceinline__ s16x4 tr_read(int vb) {
  s16x4 r; asm volatile("ds_read_b64_tr_b16 %0, %1 offset:%2" : "=&v"(r) : "v"(vb), "i"(OFF) : "memory"); return r;
}
template <int D0> __device__ __forceinline__ void pv_one(f32x16& od, int vb, bf16x8 pa0, bf16x8 pa1, bf16x8 pa2, bf16x8 pa3) {
  const s16x4 l0 = tr_read<v_rd_off(D0, 0, 0)>(vb), h0 = tr_read<v_rd_off(D0, 0, 1)>(vb), l1 = tr_read<v_rd_off(D0, 1, 0)>(vb), h1 = tr_read<v_rd_off(D0, 1, 1)>(vb);
  const s16x4 l2 = tr_read<v_rd_off(D0, 2, 0)>(vb), h2 = tr_read<v_rd_off(D0, 2, 1)>(vb), l3 = tr_read<v_rd_off(D0, 3, 0)>(vb), h3 = tr_read<v_rd_off(D0, 3, 1)>(vb);
  asm volatile("s_waitcnt lgkmcnt(0)" ::: "memory"); SBAR();
#define PK(L, H) (bf16x8){L[0], L[1], L[2], L[3], H[0], H[1], H[2], H[3]}
  od = __builtin_amdgcn_mfma_f32_32x32x16_bf16(pa0, PK(l0, h0), od, 0, 0, 0);
  od = __builtin_amdgcn_mfma_f32_32x32x16_bf16(pa1, PK(l1, h1), od, 0, 0, 0);
  od = __builtin_amdgcn_mfma_f32_32x32x16_bf16(pa2, PK(l2, h2), od, 0, 0, 0);
  od = __builtin_amdgcn_mfma_f32_32x32x16_bf16(pa3, PK(l3, h3), od, 0, 0, 0);
#undef PK
}
__device__ __forceinline__ void pv_d0(f32x16* o, int vb, bf16x8 pa0, bf16x8 pa1, bf16x8 pa2, bf16x8 pa3) {
  pv_one<0>(o[0], vb, pa0, pa1, pa2, pa3); pv_one<1>(o[1], vb, pa0, pa1, pa2, pa3); pv_one<2>(o[2], vb, pa0, pa1, pa2, pa3); pv_one<3>(o[3], vb, pa0, pa1, pa2, pa3);
}


typedef const __attribute__((address_space(3))) float* lds_cf;
__device__ __forceinline__ void nbmask(f32x16& p0, f32x16& p1, int kr, int rq, int cq, int hi, lds_cf tbl) {
  int r0 = rq - 4; r0 = r0 < 0 ? 0 : (r0 > 248 ? 248 : r0);
  int c0 = cq - 8; c0 = c0 < 0 ? 0 : (c0 > 48 ? 48 : c0);
  const bool row_ok = (unsigned)(kr - r0) < 8u;
  const unsigned long long cm = row_ok ? ((0xFFFFull << c0) >> (4 * hi)) : 0ull;
  const unsigned mlo = (unsigned)cm, mhi = (unsigned)(cm >> 32);
  const int dr = row_ok ? kr - rq + 7 : 0;
  lds_cf tb = tbl + (dr * 128 + 63 - cq + 4 * hi);
#pragma unroll
  for (int r = 0; r < 16; ++r) {
    const int bit = (r & 3) + 8 * (r >> 2);
    float b0 = tb[bit], b1 = tb[bit + 32]; asm volatile("" : "+v"(b0), "+v"(b1));
    p0[r] = (mlo & (1u << bit)) ? p0[r] + b0 : -INFINITY; p1[r] = (mhi & (1u << bit)) ? p1[r] + b1 : -INFINITY;
  }
}
#define PVRD(D0, L) do { L[0] = tr_read<v_rd_off(D0, 0, 0)>(vb); L[1] = tr_read<v_rd_off(D0, 0, 1)>(vb); L[2] = tr_read<v_rd_off(D0, 1, 0)>(vb); L[3] = tr_read<v_rd_off(D0, 1, 1)>(vb); \
    L[4] = tr_read<v_rd_off(D0, 2, 0)>(vb); L[5] = tr_read<v_rd_off(D0, 2, 1)>(vb); L[6] = tr_read<v_rd_off(D0, 3, 0)>(vb); L[7] = tr_read<v_rd_off(D0, 3, 1)>(vb); } while (0)
#define PVMM(OD, L) do { OD = __builtin_amdgcn_mfma_f32_32x32x16_bf16(pa0, PKV(L[0], L[1]), OD, 0, 0, 0); OD = __builtin_amdgcn_mfma_f32_32x32x16_bf16(pa1, PKV(L[2], L[3]), OD, 0, 0, 0); \
    OD = __builtin_amdgcn_mfma_f32_32x32x16_bf16(pa2, PKV(L[4], L[5]), OD, 0, 0, 0); OD = __builtin_amdgcn_mfma_f32_32x32x16_bf16(pa3, PKV(L[6], L[7]), OD, 0, 0, 0); } while (0)
#define PKV(L, H) (bf16x8){L[0], L[1], L[2], L[3], H[0], H[1], H[2], H[3]}
__device__ __forceinline__ void pv_d0p(f32x16* o, int vb, bf16x8 pa0, bf16x8 pa1, bf16x8 pa2, bf16x8 pa3) {
  s16x4 a[8], b[8];
  PVRD(0, a); PVRD(1, b); asm volatile("s_waitcnt lgkmcnt(8)" ::: "memory"); SBAR(); PVMM(o[0], a);
  PVRD(2, a); asm volatile("s_waitcnt lgkmcnt(8)" ::: "memory"); SBAR(); PVMM(o[1], b);
  PVRD(3, b); asm volatile("s_waitcnt lgkmcnt(8)" ::: "memory"); SBAR(); PVMM(o[2], a);
  asm volatile("s_waitcnt lgkmcnt(0)" ::: "memory"); SBAR(); PVMM(o[3], b);
}
#undef PVRD
#undef PVMM
#undef PKV
#define PVRDK(KS, L) do { L[0] = tr_read<v_rd_off(0, KS, 0)>(vb); L[1] = tr_read<v_rd_off(0, KS, 1)>(vb); L[2] = tr_read<v_rd_off(1, KS, 0)>(vb); L[3] = tr_read<v_rd_off(1, KS, 1)>(vb); \
    L[4] = tr_read<v_rd_off(2, KS, 0)>(vb); L[5] = tr_read<v_rd_off(2, KS, 1)>(vb); L[6] = tr_read<v_rd_off(3, KS, 0)>(vb); L[7] = tr_read<v_rd_off(3, KS, 1)>(vb); } while (0)
#define PKV(L, H) (bf16x8){L[0], L[1], L[2], L[3], H[0], H[1], H[2], H[3]}
#define PVMMK(PA, L) do { o[0] = __builtin_amdgcn_mfma_f32_32x32x16_bf16(PA, PKV(L[0], L[1]), o[0], 0, 0, 0); o[1] = __builtin_amdgcn_mfma_f32_32x32x16_bf16(PA, PKV(L[2], L[3]), o[1], 0, 0, 0); \
    o[2] = __builtin_amdgcn_mfma_f32_32x32x16_bf16(PA, PKV(L[4], L[5]), o[2], 0, 0, 0); o[3] = __builtin_amdgcn_mfma_f32_32x32x16_bf16(PA, PKV(L[6], L[7]), o[3], 0, 0, 0); } while (0)
__device__ __forceinline__ void pv_ks(f32x16* o, int vb, bf16x8 pa0, bf16x8 pa1, bf16x8 pa2, bf16x8 pa3) {
  s16x4 a[8], b[8];
  PVRDK(0, a); PVRDK(1, b); asm volatile("s_waitcnt lgkmcnt(8)" ::: "memory"); SBAR(); PVMMK(pa0, a);
  PVRDK(2, a); asm volatile("s_waitcnt lgkmcnt(8)" ::: "memory"); SBAR(); PVMMK(pa1, b);
  PVRDK(3, b); asm volatile("s_waitcnt lgkmcnt(8)" ::: "memory"); SBAR(); PVMMK(pa2, a);
  asm volatile("s_waitcnt lgkmcnt(0)" ::: "memory"); SBAR(); PVMMK(pa3, b);
}
#undef PVRDK
#undef PKV
#undef PVMMK
__device__ __forceinline__ void store_o_staged(const f32x16* o, const float* rli, bf16* Ow, char* stage, int lane) {
  const int r32 = lane & 31, hi = lane >> 5;
#pragma unroll
  for (int r = 0; r < 16; ++r) { const int orow = crow(r, hi);
#pragma unroll
    for (int d0 = 0; d0 < 4; ++d0) *(bf16*)(stage + orow * 256 + (d0 * 32 + r32) * 2) = __float2bfloat16(o[d0][r] * rli[r]); }
  asm volatile("s_waitcnt lgkmcnt(0)" ::: "memory");
#pragma unroll
  for (int k = 0; k < 8; ++k) { const int row = (lane >> 4) + 4 * k; const u32x4 v = *(const u32x4*)(stage + row * 256 + (lane & 15) * 16); *(u32x4*)(Ow + (long)row * LDO + (lane & 15) * 8) = v; }
}
template <bool NB>
__device__ __forceinline__ void attn_dense_body(const bf16* __restrict__ Qb, const bf16* __restrict__ Kh, const bf16* __restrict__ Vh,
                                                bf16* __restrict__ Ob, int seq, char* lds, int tq0, int krow0, int wave_s) {
  using TQ = bf16; constexpr int SDEPTH = NB ? 2 : ATT_A_SDEPTH;
  using St = Stage<bf16>; using SQ = Stage<TQ>;
  int tid_ = __builtin_amdgcn_mbcnt_hi(~0u, __builtin_amdgcn_mbcnt_lo(~0u, 0u)); asm volatile("" : "+v"(tid_)); tid_ += wave_s * 64;
  const int tid = tid_, wid = tid >> 6, lane = tid & 63, r32 = lane & 31, hi = lane >> 5;
  bf16* V_lds = (bf16*)lds; bf16* K_lds = (bf16*)(lds + 2 * SHM_V);
  float* ws = (float*)(lds + 2 * SHM_V + 2 * SHM_K) + wid * 64; float* li_l = ws; float* al_l = ws + 32;
  float m_reg = -1e30f, l_reg = 0; f32x16 o[4] = {}; bf16x8 qr[8];
  lds_cf tbl = (lds_cf)(__attribute__((address_space(3))) char*)(lds + SHM_ATTN);
  const int nb_tq = tq0 + wid * QBLK + r32, nb_rq = nb_tq >> 6, nb_cq = nb_tq & 63;
  const TQ* Qw = Qb + (long)(wid * QBLK + r32) * LDQ + hi * 8;
#pragma unroll
  for (int d0 = 0; d0 < 8; ++d0) qr[d0] = SQ::tobf(SQ::ld8(Qw + d0 * 16));
  const int sr = tid >> 4, sc = (tid & 15) * 8, vst0 = v_st(sr, sc), vst1 = v_st(32 + sr, sc);
  const int vb0 = (int)(uintptr_t)V_lds + v_rd_base(lane);
  struct { typename St::T vs0, vs1, ks0, ks1; } sr_[SDEPTH];
#define SLOAD(i, k0) do { sr_[i].vs0 = St::ld8(&Vh[(long)((k0) + sr) * LDK + sc]); sr_[i].vs1 = St::ld8(&Vh[(long)((k0) + 32 + sr) * LDK + sc]); \
    sr_[i].ks0 = St::ld8(&Kh[(long)((k0) + sr) * LDK + sc]); sr_[i].ks1 = St::ld8(&Kh[(long)((k0) + 32 + sr) * LDK + sc]); } while (0)
#define SWRITE(b, i) do { *(bf16x8*)((char*)V_lds + (b) * SHM_V + vst0) = St::tobf(sr_[i].vs0);          \
    *(bf16x8*)((char*)V_lds + (b) * SHM_V + vst1) = St::tobf(sr_[i].vs1); int kc = sc * 2;               \
    *(bf16x8*)((char*)K_lds + (b) * SHM_K + KSWZ(sr, kc)) = St::tobf(sr_[i].ks0);                       \
    *(bf16x8*)((char*)K_lds + (b) * SHM_K + KSWZ(32 + sr, kc)) = St::tobf(sr_[i].ks1); } while (0)
#define SWAIT() do { if constexpr (SDEPTH == 2) asm volatile("s_waitcnt vmcnt(4)" ::: "memory"); else asm volatile("s_waitcnt vmcnt(0)" ::: "memory"); } while (0)
#define RESC(a) do { if (__any((a) < 1.f)) { if (hi == 0) al_l[r32] = (a); asm volatile("s_waitcnt lgkmcnt(0)" ::: "memory"); \
    for (int d = 0; d < 4; ++d) for (int r = 0; r < 16; ++r) o[d][r] *= al_l[crow(r, hi)]; } } while (0)
  f32x16 pA0, pA1, pB0, pB1; float mnA, mnB, alA, alB; bf16x8 pa0, pa1, pa2, pa3; const int NT = seq / KVBLK;
  if constexpr (NB) {
    int r0w = __builtin_amdgcn_readfirstlane((tq0 + wid * QBLK) >> 6) - 4; r0w = r0w < 0 ? 0 : (r0w > 248 ? 248 : r0w);
    SLOAD(0, 0); asm volatile("s_waitcnt vmcnt(0)" ::: "memory"); SWRITE(0, 0); __syncthreads();
    SLOAD(1, KVBLK);
#define NBSTEP(t, bsel) do { if ((unsigned)(krow0 + (t) - r0w) < 8u) {   \
        SBAR(); qkt(pA0, pA1, (bf16*)((char*)K_lds + (bsel) * SHM_K), qr, r32, hi); nbmask(pA0, pA1, krow0 + (t), nb_rq, nb_cq, hi, tbl); \
        partialSM(pA0, pA1, m_reg, mnA, alA); RESC(alA); \
        finishSM(pA0, pA1, alA, l_reg, pa0, pa1, pa2, pa3); SBAR(); \
        pv_d0(o, vb0 + (bsel) * (int)SHM_V, pa0, pa1, pa2, pa3); } } while (0)
    for (int t = 0; t < NT; t += 2) {
      if (t + 2 < NT) SLOAD(0, (t + 2) * KVBLK);
      NBSTEP(t, 0);
      SWRITE(1, 1); __syncthreads();
      if (t + 3 < NT) SLOAD(1, (t + 3) * KVBLK);
      NBSTEP(t + 1, 1);
      if (t + 2 < NT) SWRITE(0, 0);
      __syncthreads();
    }
#undef NBSTEP
  } else {
  constexpr int SE = 0, SO = SDEPTH - 1;
  SLOAD(SE, 0); asm volatile("s_waitcnt vmcnt(0)" ::: "memory"); SWRITE(0, SE); __syncthreads();
  qkt(pA0, pA1, K_lds, qr, r32, hi); partialSM(pA0, pA1, m_reg, mnA, alA);
  SLOAD(SO, KVBLK); if constexpr (SDEPTH == 2) { if (2 < NT) SLOAD(SE, 2 * KVBLK); }
  SWAIT(); SWRITE(1, SO); __syncthreads();
  for (int j = 1; j + 1 < NT; j += 2) {
    SBAR(); qkt(pB0, pB1, (bf16*)((char*)K_lds + SHM_K), qr, r32, hi);
    finishSM(pA0, pA1, alA, l_reg, pa0, pa1, pa2, pa3); SBAR();
    SLOAD(SO, (j + SDEPTH) * KVBLK); SBAR();
    pv_d0(o, vb0, pa0, pa1, pa2, pa3); partialSM(pB0, pB1, m_reg, mnB, alB);
    __syncthreads(); SWAIT(); SWRITE(0, SE);
    RESC(alB); __syncthreads();
    SBAR(); qkt(pA0, pA1, K_lds, qr, r32, hi);
    finishSM(pB0, pB1, alB, l_reg, pa0, pa1, pa2, pa3); SBAR();
    if (SDEPTH == 1 || j + 3 < NT) SLOAD(SE, (j + 1 + SDEPTH) * KVBLK); SBAR();
    pv_d0(o, vb0 + (int)SHM_V, pa0, pa1, pa2, pa3); partialSM(pA0, pA1, m_reg, mnA, alA);
    __syncthreads(); SWAIT(); SWRITE(1, SO);
    RESC(alA); __syncthreads();
  }
  SBAR(); qkt(pB0, pB1, (bf16*)((char*)K_lds + SHM_K), qr, r32, hi);
  finishSM(pA0, pA1, alA, l_reg, pa0, pa1, pa2, pa3); SBAR();
  pv_d0(o, vb0, pa0, pa1, pa2, pa3); partialSM(pB0, pB1, m_reg, mnB, alB);
  __syncthreads(); RESC(alB);
  finishSM(pB0, pB1, alB, l_reg, pa0, pa1, pa2, pa3); SBAR();
  pv_d0(o, vb0 + (int)SHM_V, pa0, pa1, pa2, pa3);
  }
  if (hi == 0) li_l[r32] = l_reg; asm volatile("s_waitcnt lgkmcnt(0)" ::: "memory");
  float rli[16];
#pragma unroll
  for (int r = 0; r < 16; ++r) rli[r] = __builtin_amdgcn_rcpf(li_l[crow(r, hi)]);
  bf16* Ow = Ob + (long)(wid * QBLK) * LDO;
  __syncthreads();
  store_o_staged(o, rli, Ow, lds + wid * 8192, lane);
  __syncthreads();
#undef SLOAD
#undef SWRITE
#undef SWAIT
#undef RESC
}

constexpr int RING = 3, DMA_K0 = 0, DMA_V0 = RING * (int)SHM_K, DMA_WS = 2 * RING * (int)SHM_K; constexpr int PP_TBL = DMA_WS + 2048;
#define DMA16(gp, loff) __builtin_amdgcn_global_load_lds((const unsigned*)(gp), (__attribute__((address_space(3))) unsigned*)((__attribute__((address_space(3))) char*)lds_as + (loff)), 16, 0, 0)
__device__ __forceinline__ void attn_dense_dma(const bf16* __restrict__ Qb, const bf16* __restrict__ Kh, const bf16* __restrict__ Vh, bf16* __restrict__ Ob, int seq, char* lds, int wave_s) {
  int tid_ = __builtin_amdgcn_mbcnt_hi(~0u, __builtin_amdgcn_mbcnt_lo(~0u, 0u)); asm volatile("" : "+v"(tid_));
  const int lane = tid_, wid = wave_s, r32 = lane & 31, hi = lane >> 5;
  __attribute__((address_space(3))) char* lds_as = (__attribute__((address_space(3))) char*)lds;
  float* ws = (float*)(lds + DMA_WS) + wid * 64; float* li_l = ws; float* al_l = ws + 32;
  float m_reg = -1e30f, l_reg = 0; f32x16 o[4] = {}; bf16x8 qr[8];
  const bf16* Qw = Qb + (long)(wid * QBLK + r32) * LDQ + hi * 8;
#pragma unroll
  for (int d0 = 0; d0 < 8; ++d0) qr[d0] = *reinterpret_cast<const bf16x8*>(Qw + d0 * 16);
  unsigned koff[2], voff[2];
#pragma unroll
  for (int q = 0; q < 2; ++q) { const int P = wid * 2 + q;
    { const int row = 4 * P + (lane >> 4), c = (lane & 15) ^ (row & 7); koff[q] = (unsigned)(row * LDK + c * 8) * 2u; }
    { const int sI = 2 * P + (lane >> 5), ch = lane & 31, kk = (sI >> 2) * 8 + (ch >> 2), cc = (sI & 3) * 32 + (ch & 3) * 8, k = (kk & ~0xC) | ((kk & 4) << 1) | ((kk & 8) >> 1); voff[q] = (unsigned)(k * LDK + cc) * 2u; } }
  const int pbase = wid * 2048;
  const int NT = seq / KVBLK; const size_t tstep = (size_t)KVBLK * LDK * 2;
#define DMA_K(t, slot) do { const char* g_ = (const char*)Kh + (size_t)(t) * tstep; DMA16(g_ + koff[0], DMA_K0 + (slot) * (int)SHM_K + pbase); DMA16(g_ + koff[1], DMA_K0 + (slot) * (int)SHM_K + pbase + 1024); } while (0)
#define DMA_V(t, slot) do { const char* g_ = (const char*)Vh + (size_t)(t) * tstep; DMA16(g_ + voff[0], DMA_V0 + (slot) * (int)SHM_V + pbase); DMA16(g_ + voff[1], DMA_V0 + (slot) * (int)SHM_V + pbase + 1024); } while (0)
#define STEP_END() do { asm volatile("s_waitcnt vmcnt(4) lgkmcnt(0)" ::: "memory"); __builtin_amdgcn_s_barrier(); asm volatile("" ::: "memory"); } while (0)
#define RESC(a) do { if (__any((a) < 1.f)) { if (hi == 0) al_l[r32] = (a); asm volatile("s_waitcnt lgkmcnt(0)" ::: "memory"); \
    for (int d = 0; d < 4; ++d) for (int r = 0; r < 16; ++r) o[d][r] *= al_l[crow(r, hi)]; } } while (0)
#define KPTR(slot) ((const bf16*)(lds + DMA_K0 + (slot) * (int)SHM_K))
  const int vb0 = (int)(uintptr_t)(lds + DMA_V0) + v_rd_base(lane);
  f32x16 pA0, pA1, pB0, pB1; float mnA, mnB, alA, alB; bf16x8 pa0, pa1, pa2, pa3;
  DMA_K(0, 0); DMA_V(0, 0); DMA_K(1, 1);
  asm volatile("s_waitcnt vmcnt(2)" ::: "memory"); __builtin_amdgcn_s_barrier(); asm volatile("" ::: "memory");
  DMA_K(2, 2); DMA_V(1, 1);
  SBAR(); qkt(pA0, pA1, KPTR(0), qr, r32, hi); partialSM(pA0, pA1, m_reg, mnA, alA);
  STEP_END();
  int s0 = 1, s1 = 2, s2 = 0;
  for (int j = 1; j + 1 < NT; j += 2) {
    { const int tk = j + 2 < NT ? j + 2 : NT - 1; DMA_K(tk, s2); DMA_V(j + 1, s1); }
    SBAR(); qkt(pB0, pB1, KPTR(s0), qr, r32, hi);
    finishSM(pA0, pA1, alA, l_reg, pa0, pa1, pa2, pa3); SBAR();
    pv_d0p(o, vb0 + s2 * (int)SHM_V, pa0, pa1, pa2, pa3);
    partialSM(pB0, pB1, m_reg, mnB, alB); RESC(alB);
    STEP_END();
    { const int tk = j + 3 < NT ? j + 3 : NT - 1, tv = j + 2 < NT ? j + 2 : NT - 1; DMA_K(tk, s0); DMA_V(tv, s2); }
    SBAR(); qkt(pA0, pA1, KPTR(s1), qr, r32, hi);
    finishSM(pB0, pB1, alB, l_reg, pa0, pa1, pa2, pa3); SBAR();
    pv_d0p(o, vb0 + s0 * (int)SHM_V, pa0, pa1, pa2, pa3);
    partialSM(pA0, pA1, m_reg, mnA, alA); RESC(alA);
    STEP_END();
    { const int t_ = s0; s0 = s2; s2 = s1; s1 = t_; }
  }
  SBAR(); qkt(pB0, pB1, KPTR(s0), qr, r32, hi);
  finishSM(pA0, pA1, alA, l_reg, pa0, pa1, pa2, pa3); SBAR();
  pv_d0p(o, vb0 + s2 * (int)SHM_V, pa0, pa1, pa2, pa3);
  partialSM(pB0, pB1, m_reg, mnB, alB); RESC(alB);
  finishSM(pB0, pB1, alB, l_reg, pa0, pa1, pa2, pa3);
  asm volatile("s_waitcnt vmcnt(0) lgkmcnt(0)" ::: "memory"); __builtin_amdgcn_s_barrier(); asm volatile("" ::: "memory"); SBAR();
  pv_d0p(o, vb0 + s0 * (int)SHM_V, pa0, pa1, pa2, pa3);
  if (hi == 0) li_l[r32] = l_reg; asm volatile("s_waitcnt lgkmcnt(0)" ::: "memory");
  float rli[16];
#pragma unroll
  for (int r = 0; r < 16; ++r) rli[r] = __builtin_amdgcn_rcpf(li_l[crow(r, hi)]);
  bf16* Ow = Ob + (long)(wid * QBLK) * LDO;
#pragma unroll
  for (int r = 0; r < 16; ++r) { int orow = crow(r, hi);
    for (int d0 = 0; d0 < 4; ++d0) Ow[(long)orow * LDO + d0 * 32 + r32] = __float2bfloat16(o[d0][r] * rli[r]); }
  asm volatile("s_waitcnt lgkmcnt(0)" ::: "memory"); __builtin_amdgcn_s_barrier(); asm volatile("" ::: "memory");
#undef DMA_K
#undef DMA_V
#undef STEP_END
#undef RESC
#undef KPTR
}
#undef DMA16


template <int OFF> __device__ __forceinline__ bf16x8 k_read(int addr) { bf16x8 r; asm volatile("ds_read_b128 %0, %1 offset:%2" : "=&v"(r) : "v"(addr), "i"(OFF) : "memory"); return r; }
#define KRD(D0, X0, X1) do { X0 = k_read<((D0) >> 2) * 128>(ka[(D0) & 3]); X1 = k_read<((D0) >> 2) * 128 + 8192>(ka[(D0) & 3]); } while (0)
#define KMM(D0, X0, X1) do { p0 = __builtin_amdgcn_mfma_f32_32x32x16_bf16(X0, qr[D0], p0, 0, 0, 0); p1 = __builtin_amdgcn_mfma_f32_32x32x16_bf16(X1, qr[D0], p1, 0, 0, 0); } while (0)
#define KW(N) do { asm volatile("s_waitcnt lgkmcnt(" #N ")" ::: "memory"); SBAR(); } while (0)
struct KFr { bf16x8 a0, a1, b0, b1, c0, c1; };
__device__ __forceinline__ void qkt_p_begin(KFr& f, const int (&ka)[4]) { KRD(0, f.a0, f.a1); KRD(1, f.b0, f.b1); KRD(2, f.c0, f.c1); }
__device__ __forceinline__ void qkt_p_rest(KFr& f, f32x16& p0, f32x16& p1, const int (&ka)[4], const bf16x8* qr) {
  p0 = f32x16{}; p1 = f32x16{};
  KW(4); KMM(0, f.a0, f.a1); KRD(3, f.a0, f.a1);
  KW(4); KMM(1, f.b0, f.b1); KRD(4, f.b0, f.b1);
  KW(4); KMM(2, f.c0, f.c1); KRD(5, f.c0, f.c1);
  KW(4); KMM(3, f.a0, f.a1); KRD(6, f.a0, f.a1);
  KW(4); KMM(4, f.b0, f.b1); KRD(7, f.b0, f.b1);
  KW(4); KMM(5, f.c0, f.c1);
  KW(2); KMM(6, f.a0, f.a1);
  KW(0); KMM(7, f.b0, f.b1);
}
#undef KRD
#undef KMM
#undef KW
#define DMA16(gp, loff) __builtin_amdgcn_global_load_lds((const unsigned*)(gp), (__attribute__((address_space(3))) unsigned*)((__attribute__((address_space(3))) char*)lds_as + (loff)), 16, 0, 0)
template <bool NB>
__device__ __forceinline__ void attn_dense_pp(const bf16* __restrict__ Qb, const bf16* __restrict__ Kh, const bf16* __restrict__ Vh, bf16* __restrict__ Ob, int seq, char* lds, int wave_s, const float* __restrict__ gq, int tq0, int krow0) {
  int tid_ = __builtin_amdgcn_mbcnt_hi(~0u, __builtin_amdgcn_mbcnt_lo(~0u, 0u)); asm volatile("" : "+v"(tid_));
  const int lane = tid_, wid = wave_s, r32 = lane & 31, hi = lane >> 5;
  __attribute__((address_space(3))) char* lds_as = (__attribute__((address_space(3))) char*)lds;
  float* ws = (float*)(lds + DMA_WS) + wid * 64; float* li_l = ws; float* al_l = ws + 32;
  float m_reg = -1e30f, l_reg = 0; f32x16 o[4] = {}; bf16x8 qr[8];
  const bf16* Qw = Qb + (long)(wid * QBLK + r32) * LDQ + hi * 8;
#pragma unroll
  for (int d0 = 0; d0 < 8; ++d0) qr[d0] = *reinterpret_cast<const bf16x8*>(Qw + d0 * 16);
  if constexpr (!NB) { float qf[8][8]; float ss = 0.f;
#pragma unroll
    for (int d0 = 0; d0 < 8; ++d0)
#pragma unroll
      for (int e = 0; e < 8; ++e) { qf[d0][e] = __builtin_bit_cast(float, (unsigned)(unsigned short)qr[d0][e] << 16); ss += qf[d0][e] * qf[d0][e]; }
    { auto rr = __builtin_amdgcn_permlane32_swap(__float_as_uint(ss), __float_as_uint(ss), false, false); ss = __uint_as_float(rr[0]) + __uint_as_float(rr[1]); }
    const float rs = rsqrtf(ss * (1.f / 128.f) + 1e-6f);
#pragma unroll
    for (int d0 = 0; d0 < 8; ++d0) { const f32x8 gv = *reinterpret_cast<const f32x8*>(gq + d0 * 16 + hi * 8);
#pragma unroll
      for (int e = 0; e < 8; ++e) qf[d0][e] *= rs * gv[e]; }
    const int tq = tq0 + wid * QBLK + r32;
#pragma unroll
    for (int h = 0; h < 2; ++h) { const float posf = (float)(h ? (tq & 63) : (tq >> 6));
#pragma unroll
      for (int dl = 0; dl < 2; ++dl)
#pragma unroll
        for (int e = 0; e < 8; ++e) { const float freq = exp2f(-(float)(dl * 16 + hi * 8 + e) * (13.287712379549449f / 32.f)); const float ang = posf * freq;
          double rev = (double)ang * 0.15915494309189535; rev -= floor(rev); const float fr = (float)rev; const float sn = __builtin_amdgcn_sinf(fr), cs = __builtin_amdgcn_cosf(fr);
          const float x1 = qf[4 * h + dl][e], x2 = qf[4 * h + dl + 2][e]; qf[4 * h + dl][e] = x1 * cs - x2 * sn; qf[4 * h + dl + 2][e] = x2 * cs + x1 * sn; } }
#pragma unroll
    for (int d0 = 0; d0 < 8; ++d0) { u32x4 w = {cvtpk(qf[d0][0], qf[d0][1]), cvtpk(qf[d0][2], qf[d0][3]), cvtpk(qf[d0][4], qf[d0][5]), cvtpk(qf[d0][6], qf[d0][7])}; qr[d0] = *reinterpret_cast<bf16x8*>(&w); } }
  unsigned koff[2], voff[2];
#pragma unroll
  for (int q = 0; q < 2; ++q) { const int P = wid * 2 + q;
    { const int row = 4 * P + (lane >> 4), c = (lane & 15) ^ (row & 7); koff[q] = (unsigned)(row * LDK + c * 8) * 2u; }
    { const int sI = 2 * P + (lane >> 5), ch = lane & 31, kk = (sI >> 2) * 8 + (ch >> 2), cc = (sI & 3) * 32 + (ch & 3) * 8, k = (kk & ~0xC) | ((kk & 4) << 1) | ((kk & 8) >> 1); voff[q] = (unsigned)(k * LDK + cc) * 2u; } }
  const int pbase = wid * 2048;
  const int NT = seq / KVBLK; const size_t tstep = (size_t)KVBLK * LDK * 2;
#define DMA_K(t, slot) do { const char* g_ = (const char*)Kh + (size_t)(t) * tstep; DMA16(g_ + koff[0], DMA_K0 + (slot) * (int)SHM_K + pbase); DMA16(g_ + koff[1], DMA_K0 + (slot) * (int)SHM_K + pbase + 1024); } while (0)
#define DMA_V(t, slot) do { const char* g_ = (const char*)Vh + (size_t)(t) * tstep; DMA16(g_ + voff[0], DMA_V0 + (slot) * (int)SHM_V + pbase); DMA16(g_ + voff[1], DMA_V0 + (slot) * (int)SHM_V + pbase + 1024); } while (0)
#define HALF_END() do { SBAR(); asm volatile("s_waitcnt vmcnt(4) lgkmcnt(0)" ::: "memory"); __builtin_amdgcn_s_barrier(); asm volatile("" ::: "memory"); SBAR(); } while (0)
#define RESC(a) do { if (__any((a) < 1.f)) { if (hi == 0) al_l[r32] = (a); asm volatile("s_waitcnt lgkmcnt(0)" ::: "memory"); \
    for (int d = 0; d < 4; ++d) for (int r = 0; r < 16; ++r) o[d][r] *= al_l[crow(r, hi)]; } } while (0)
#define KPTR(slot) ((const bf16*)(lds + DMA_K0 + (slot) * (int)SHM_K))
  const int vb0 = (int)(uintptr_t)(lds + DMA_V0) + v_rd_base(lane);
  int kb[4];
#pragma unroll
  for (int k = 0; k < 4; ++k) kb[k] = (int)(uintptr_t)(lds + DMA_K0) + r32 * 256 + ((k * 32 + hi * 16) ^ ((r32 & 7) << 4));
#define QKT(slot, ...) do { const int so_ = (slot) * (int)SHM_K; const int ka_[4] = {kb[0] + so_, kb[1] + so_, kb[2] + so_, kb[3] + so_}; KFr f_; qkt_p_begin(f_, ka_); __VA_ARGS__; qkt_p_rest(f_, p0, p1, ka_, qr); } while (0)
  f32x16 p0, p1; float mn, al = 1.f; bf16x8 pa0, pa1, pa2, pa3;
  lds_cf tbl = (lds_cf)(__attribute__((address_space(3))) char*)(lds + PP_TBL);
  const int nb_tq = tq0 + wid * QBLK + r32, nb_rq = nb_tq >> 6, nb_cq = nb_tq & 63;
  int nb_r0w = __builtin_amdgcn_readfirstlane((tq0 + wid * QBLK) >> 6) - 4; nb_r0w = nb_r0w < 0 ? 0 : (nb_r0w > 248 ? 248 : nb_r0w);
#define ACT(t) (!NB || (unsigned)(krow0 + (t) - nb_r0w) < 8u)
  DMA_K(0, 0); DMA_V(0, 0); DMA_K(1, 1);
  asm volatile("s_waitcnt vmcnt(2)" ::: "memory"); __builtin_amdgcn_s_barrier(); asm volatile("" ::: "memory"); SBAR();
  if (wid >= 4) { __builtin_amdgcn_s_barrier(); asm volatile("" ::: "memory"); SBAR(); }
  SBAR(); if (ACT(0)) QKT(0, do { DMA_K(2, 2); DMA_V(1, 1); } while (0)); else { DMA_K(2, 2); DMA_V(1, 1); }
  HALF_END();
  if (ACT(0)) { if constexpr (NB) nbmask(p0, p1, krow0, nb_rq, nb_cq, hi, tbl); partialSM(p0, p1, m_reg, mn, al); finishSM(p0, p1, al, l_reg, pa0, pa1, pa2, pa3); }
  HALF_END();
  int s0 = 1, s1 = 2, s2 = 0;
  for (int j = 1; j < NT; ++j) {
    SBAR();
    if (ACT(j)) QKT(s0, do { const int tk = j + 2 < NT ? j + 2 : NT - 1, tv = j + 1 < NT ? j + 1 : NT - 1; DMA_K(tk, s2); DMA_V(tv, s1); } while (0));
    else { const int tk = j + 2 < NT ? j + 2 : NT - 1, tv = j + 1 < NT ? j + 1 : NT - 1; DMA_K(tk, s2); DMA_V(tv, s1); }
    if (ACT(j - 1)) pv_ks(o, vb0 + s2 * (int)SHM_V, pa0, pa1, pa2, pa3);
    HALF_END();
    if (ACT(j)) { if constexpr (NB) nbmask(p0, p1, krow0 + j, nb_rq, nb_cq, hi, tbl);
      partialSM(p0, p1, m_reg, mn, al); RESC(al);
      finishSM(p0, p1, al, l_reg, pa0, pa1, pa2, pa3); }
    HALF_END();
    { const int t_ = s0; s0 = s1; s1 = s2; s2 = t_; }
  }
  asm volatile("s_waitcnt vmcnt(0)" ::: "memory");
  if (ACT(NT - 1)) pv_ks(o, vb0 + s2 * (int)SHM_V, pa0, pa1, pa2, pa3);
  if (wid < 4) { SBAR(); asm volatile("s_waitcnt lgkmcnt(0)" ::: "memory"); __builtin_amdgcn_s_barrier(); asm volatile("" ::: "memory"); SBAR(); }
  SBAR(); asm volatile("s_waitcnt lgkmcnt(0)" ::: "memory"); __builtin_amdgcn_s_barrier(); asm volatile("" ::: "memory"); SBAR();
  if (hi == 0) li_l[r32] = l_reg; asm volatile("s_waitcnt lgkmcnt(0)" ::: "memory");
  float rli[16];
#pragma unroll
  for (int r = 0; r < 16; ++r) rli[r] = __builtin_amdgcn_rcpf(li_l[crow(r, hi)]);
  bf16* Ow = Ob + (long)(wid * QBLK) * LDO;
  store_o_staged(o, rli, Ow, lds + wid * 8192, lane);
  asm volatile("s_waitcnt vmcnt(0) lgkmcnt(0)" ::: "memory"); __builtin_amdgcn_s_barrier(); asm volatile("" ::: "memory");
#undef DMA_K
#undef DMA_V
#undef HALF_END
#undef RESC
#undef KPTR
#undef QKT
#undef ACT
}
#undef DMA16

#undef KSWZ
}
#ifndef MK_N_LAUNCHES
#define MK_N_LAUNCHES 1
#endif
constexpr int NWAVES = 8, NTHR = NWAVES * 64;
constexpr int S = 16384, DM = 2048, INW = 4608, DFF = 8192, PLE = 256, NPH = 11;
constexpr float EPS = 1e-6f;
typedef unsigned short bf16r;
typedef float f32x4 __attribute__((ext_vector_type(4)));
typedef unsigned v4u __attribute__((ext_vector_type(4)));
typedef unsigned v2u __attribute__((ext_vector_type(2)));
#define LAS __attribute__((address_space(3)))
#define GAS __attribute__((address_space(1)))
constexpr size_t MiB = 1u << 20;
constexpr size_t WS_WIN = 1 * MiB, WS_WO = 19 * MiB, WS_WUP = 27 * MiB, WS_WDN = 59 * MiB, WS_WG = 91 * MiB, WS_WP = 99 * MiB;
constexpr size_t WS_PBF = 100 * MiB;
constexpr size_t WS_A = 108 * MiB;
constexpr size_t WS_B = 364 * MiB;
constexpr size_t WS_END = 492 * MiB;
constexpr int LDS_BYTES = 147456; constexpr int MISC_OFF = 131072 + 320;
constexpr size_t WS_RS0 = 65536, WS_RS2 = 131072, WS_RS3 = 196608;
constexpr size_t WS_CTL = 0, CTL_ZERO_BYTES = 16384;

__device__ __forceinline__ unsigned f2bf(float f) { unsigned u = __builtin_bit_cast(unsigned, f); return (u + 0x7fffu + ((u >> 16) & 1u)) >> 16; }
__device__ __forceinline__ unsigned pk2(float lo, float hi) { return f2bf(lo) | (f2bf(hi) << 16); }
__device__ __forceinline__ float bf2f(unsigned short b) { return __builtin_bit_cast(float, (unsigned)b << 16); }
__device__ __forceinline__ float wave_sum(float v) {
#pragma unroll
    for (int o = 1; o < 64; o <<= 1) v += __shfl_xor(v, o);
    return v;
}
__device__ __forceinline__ void p0_transpose_item(const float* __restrict__ W, int K, int N, bf16r* __restrict__ WT, LAS float* scr, int item, int lane, const float* __restrict__ gk = nullptr) {
    const int nblk = N / 32, kb = item / nblk, nb = item % nblk, k0 = 64 * kb, n0 = 32 * nb;
    const float gv = gk ? gk[k0 + lane] : 1.f;
#pragma unroll
    for (int i = 0; i < 32; ++i) { const int kk = 2 * i + (lane >> 5); const float g_lo = __builtin_bit_cast(float, __builtin_amdgcn_readlane(__builtin_bit_cast(int, gv), 2 * i)), g_hi = __builtin_bit_cast(float, __builtin_amdgcn_readlane(__builtin_bit_cast(int, gv), 2 * i + 1)); const float gsel = (lane >> 5) ? g_hi : g_lo;
        scr[kk * 33 + (lane & 31)] = W[(size_t)(k0 + kk) * N + n0 + (lane & 31)] * gsel; }
    asm volatile("s_waitcnt lgkmcnt(0)" ::: "memory");
    const int c = lane & 7;
#pragma unroll
    for (int j = 0; j < 4; ++j) { const int n = (lane >> 3) + 8 * j; const LAS float* s = scr + (8 * c) * 33 + n;
        v4u o; o.x = pk2(s[0 * 33], s[1 * 33]); o.y = pk2(s[2 * 33], s[3 * 33]); o.z = pk2(s[4 * 33], s[5 * 33]); o.w = pk2(s[6 * 33], s[7 * 33]);
        *(v4u*)(WT + (size_t)(n0 + n) * K + k0 + 8 * c) = o; }
    asm volatile("s_waitcnt lgkmcnt(0)" ::: "memory");
}
__device__ __forceinline__ void row_norm_bf16(const float* __restrict__ xrow, bf16r* __restrict__ orow, float* __restrict__ rsout, int lane) {
    const f32x4* xr = (const f32x4*)xrow + lane;
    f32x4 v[8]; float s = 0.f;
#pragma unroll
    for (int j = 0; j < 8; ++j) { v[j] = xr[64 * j]; s += (v[j].x * v[j].x + v[j].y * v[j].y) + (v[j].z * v[j].z + v[j].w * v[j].w); }
    const float rs = rsqrtf(wave_sum(s) * (1.f / DM) + EPS);
    if (lane == 0) *rsout = rs;
    v2u* o8 = (v2u*)orow + lane;
#pragma unroll
    for (int j = 0; j < 8; ++j) { v2u w; w.x = pk2(v[j].x, v[j].y); w.y = pk2(v[j].z, v[j].w); o8[64 * j] = w; }
}
template <int XN  , bool RB, bool HB>
__device__ __forceinline__ void row_res_norm(const void* res, const bf16r* __restrict__ trow, const float* __restrict__ gpost, const float* __restrict__ gpre,
                                             void* hout, bf16r* __restrict__ xnout, int lane, float* __restrict__ rsout = nullptr) {
    const v4u* tr = (const v4u*)trow + lane; const f32x4* gp = (const f32x4*)gpost + 2 * lane;
    float t[4][8]; f32x4 h[4][2]; float s = 0.f;
#pragma unroll
    for (int j = 0; j < 4; ++j) { const v4u raw = tr[64 * j];
        if constexpr (RB) { const v4u rw = ((const v4u*)res + lane)[64 * j];
            h[j][0] = (f32x4){__builtin_bit_cast(float, rw.x << 16), __builtin_bit_cast(float, rw.x & 0xffff0000u), __builtin_bit_cast(float, rw.y << 16), __builtin_bit_cast(float, rw.y & 0xffff0000u)};
            h[j][1] = (f32x4){__builtin_bit_cast(float, rw.z << 16), __builtin_bit_cast(float, rw.z & 0xffff0000u), __builtin_bit_cast(float, rw.w << 16), __builtin_bit_cast(float, rw.w & 0xffff0000u)}; }
        else { const f32x4* rr = (const f32x4*)res + 2 * lane; h[j][0] = rr[128 * j]; h[j][1] = rr[128 * j + 1]; }
#pragma unroll
        for (int e = 0; e < 4; ++e) { t[j][2 * e] = __builtin_bit_cast(float, raw[e] << 16); t[j][2 * e + 1] = __builtin_bit_cast(float, raw[e] & 0xffff0000u); }
#pragma unroll
        for (int e = 0; e < 8; ++e) s += t[j][e] * t[j][e]; }
    const float rs = rsqrtf(wave_sum(s) * (1.f / DM) + EPS);
    float s2 = 0.f;
#pragma unroll
    for (int j = 0; j < 4; ++j) {
#pragma unroll
        for (int q = 0; q < 2; ++q) { const f32x4 gj = gp[128 * j + q]; const f32x4 tv = {t[j][4 * q], t[j][4 * q + 1], t[j][4 * q + 2], t[j][4 * q + 3]};
            h[j][q] = h[j][q] + tv * rs * gj;
            if constexpr (!HB) ((f32x4*)hout + 2 * lane)[128 * j + q] = h[j][q];
            s2 += (h[j][q].x * h[j][q].x + h[j][q].y * h[j][q].y) + (h[j][q].z * h[j][q].z + h[j][q].w * h[j][q].w); }
        if constexpr (HB) { v4u w; w.x = pk2(h[j][0].x, h[j][0].y); w.y = pk2(h[j][0].z, h[j][0].w); w.z = pk2(h[j][1].x, h[j][1].y); w.w = pk2(h[j][1].z, h[j][1].w); ((v4u*)hout + lane)[64 * j] = w; } }
    if constexpr (XN == 2) { const float rs2 = rsqrtf(wave_sum(s2) * (1.f / DM) + EPS); if (lane == 0) *rsout = rs2; }
    if constexpr (XN == 1) {
        const float rs2 = rsqrtf(wave_sum(s2) * (1.f / DM) + EPS);
        const f32x4* gq = (const f32x4*)gpre + 2 * lane; v4u* o16 = (v4u*)xnout + lane;
#pragma unroll
        for (int j = 0; j < 4; ++j) { const f32x4 g0 = gq[128 * j], g1 = gq[128 * j + 1]; v4u w;
            w.x = pk2(h[j][0].x * rs2 * g0.x, h[j][0].y * rs2 * g0.y); w.y = pk2(h[j][0].z * rs2 * g0.z, h[j][0].w * rs2 * g0.w);
            w.z = pk2(h[j][1].x * rs2 * g1.x, h[j][1].y * rs2 * g1.y); w.w = pk2(h[j][1].z * rs2 * g1.z, h[j][1].w * rs2 * g1.w); o16[64 * j] = w; }
    }
}

#define XB_TMO      128
#define XB_XCNT(j)  (256  + 64 * (j))
#define XB_XSUB(j)  (1280 + 64 * (j))
#define XB_XGEN(j)  (2304 + 64 * (j))
#define XB_TOP      3328
#define XB_TOPGEN   3392
#define XCD_BAR_WORDS 3456
#define XB_SPIN_CAP (1u << 18)

__device__ __forceinline__ unsigned xb_ld(unsigned* p)              { return __hip_atomic_load(p, __ATOMIC_RELAXED, __HIP_MEMORY_SCOPE_AGENT); }
__device__ __forceinline__ unsigned xb_add(unsigned* p, unsigned v) { return __hip_atomic_fetch_add(p, v, __ATOMIC_RELAXED, __HIP_MEMORY_SCOPE_AGENT); }
__device__ __forceinline__ unsigned xb_xcc_id() { return (unsigned)__builtin_amdgcn_s_getreg((3 << 11) | 20) & 0xFu; }
#define XB_SPIN(cond, bar) do { unsigned _sp = 0; while (cond) { __builtin_amdgcn_s_sleep(1); \
    if ((++_sp & 255u) == 0u) { if (xb_ld(&(bar)[XB_TMO])) break; if (_sp > XB_SPIN_CAP) { atomicAdd(&(bar)[XB_TMO], 1u); break; } } } } while (0)

struct XcdBarrier {
    bool t0;
    unsigned* bar; unsigned x;
    volatile LAS unsigned* st;
};

__device__ __forceinline__ XcdBarrier xcd_barrier_post(unsigned* bar, volatile LAS unsigned* st) {
    XcdBarrier b; b.t0 = threadIdx.x == 0; b.bar = bar; b.x = xb_xcc_id(); b.st = st;
    if (threadIdx.x == 0) (void)xb_add(&bar[XB_XCNT(b.x)], 1u);
    return b;
}
__device__ __forceinline__ void xcd_barrier_complete(unsigned* bar, unsigned x, unsigned& nloc, unsigned& nx) {
    const unsigned G = gridDim.x * gridDim.y * gridDim.z;
    unsigned sum, cnt, mine, sp = 0u;
    for (;;) {
        sum = 0u; cnt = 0u; mine = 0u;
#pragma unroll
        for (unsigned j = 0; j < 16; ++j) { const unsigned c = xb_ld(&bar[XB_XCNT(j)]); sum += c; cnt += (c > 0u) ? 1u : 0u; mine = (j == x) ? c : mine; }
        if (sum == G) break;
        __builtin_amdgcn_s_sleep(1);
        if ((++sp & 255u) == 0u) { if (xb_ld(&bar[XB_TMO])) break; if (sp > XB_SPIN_CAP) { atomicAdd(&bar[XB_TMO], 1u); break; } }
    }
    nloc = mine > 0u ? mine : 1u; nx = cnt > 0u ? cnt : 1u;
}

__device__ __forceinline__ void xcd_barrier(const XcdBarrier& b) {
    asm volatile("s_waitcnt vmcnt(0)" ::: "memory");
    __syncthreads();
    if (b.t0) {
        unsigned* bar = b.bar;
        __builtin_amdgcn_s_waitcnt(0);
        unsigned nloc = b.st[0], nx = b.st[1];
        if (nloc == 0u) { xcd_barrier_complete(bar, b.x, nloc, nx); b.st[0] = nloc; b.st[1] = nx; }
        const unsigned old = xb_add(&bar[XB_XSUB(b.x)], 1u);
        const unsigned gen = old / nloc;
        if (old + 1u == (gen + 1u) * nloc) {
            __builtin_amdgcn_fence(__ATOMIC_RELEASE, "agent");
            asm volatile("s_waitcnt vmcnt(0)" ::: "memory");
            const unsigned og = xb_add(&bar[XB_TOP], 1u);
            const unsigned tg = og / nx;
            if (og + 1u == (tg + 1u) * nx) xb_add(&bar[XB_TOPGEN], 1u);
            else XB_SPIN(xb_ld(&bar[XB_TOPGEN]) == tg, bar);
            __builtin_amdgcn_fence(__ATOMIC_ACQUIRE, "agent");
            xb_add(&bar[XB_XGEN(b.x)], 1u);
            asm volatile("s_waitcnt vmcnt(0)" ::: "memory");
        } else {
            XB_SPIN(xb_ld(&bar[XB_XGEN(b.x)]) == gen, bar);
            __builtin_amdgcn_fence(__ATOMIC_ACQUIRE, "agent");
            asm volatile("s_waitcnt vmcnt(0)" ::: "memory");
        }
    }
    __syncthreads();
}
#define A_X        (args.in[0])
#define A_P        (args.in[1])
#define A_GPREMIX  (args.in[2])
#define A_WIN      (args.in[3])
#define A_GQ       (args.in[4])
#define A_GK       (args.in[5])
#define A_RPB      (args.in[6])
#define A_WO       (args.in[7])
#define A_GPOSTMIX (args.in[8])
#define A_GPREMLP  (args.in[9])
#define A_WUP      (args.in[10])
#define A_WDN      (args.in[11])
#define A_GPOSTMLP (args.in[12])
#define A_GPREPLE  (args.in[13])
#define A_WGATE    (args.in[14])
#define A_WPLE     (args.in[15])
#define A_GPOSTPLE (args.in[16])
#define W_(off)    (args.ws + (off))
struct Args { const float* in[17]; float* out; unsigned char* ws; int ph_lo, ph_hi; };

__global__ void __launch_bounds__(NTHR, 2) mega_fwd(Args args) {
    extern __shared__ __attribute__((aligned(16))) unsigned char lds[];
    const int G = gridDim.x, bx = blockIdx.x, NGW = G * NWAVES;
    const int wave_s = __builtin_amdgcn_readfirstlane((int)threadIdx.x >> 6);
#define LANEVARS int lane_ = __builtin_amdgcn_mbcnt_hi(~0u, __builtin_amdgcn_mbcnt_lo(~0u, 0u)); asm volatile("" : "+v"(lane_)); const int lane = lane_, wave = wave_s, tid = wave * 64 + lane, gw = bx * NWAVES + wave; (void)lane; (void)gw; (void)tid;
    const int lo = args.ph_lo, hi = args.ph_hi;
#ifdef ONLY_PHASE
#define IN(k) ((k) == ONLY_PHASE && lo <= (k) && (k) < hi)
#else
#define IN(k) (lo <= (k) && (k) < hi)
#endif
#ifdef PROBE_K
#define STAMP(k) do { if (bx == 0 && wave_s == 0 && __builtin_amdgcn_mbcnt_hi(~0u, __builtin_amdgcn_mbcnt_lo(~0u, 0u)) == 0) ((volatile LAS unsigned*)((LAS unsigned char*)lds + MISC_OFF))[16 + (k)] = (unsigned)__builtin_amdgcn_s_memrealtime(); } while (0)
#else
#define STAMP(k) do { } while (0)
#endif
#define SEAM(k) do { if (IN(k) && IN((k) + 1)) { { XcdBarrier xb_; xb_.t0 = (wave_s == 0) && (__builtin_amdgcn_mbcnt_hi(~0u, __builtin_amdgcn_mbcnt_lo(~0u, 0u)) == 0); xb_.bar = (unsigned*)args.ws; xb_.x = xb_xcc_id(); xb_.st = (volatile LAS unsigned*)((LAS unsigned char*)lds + MISC_OFF) + 8; xcd_barrier(xb_); } } } while (0)
    LAS unsigned char* ldsl = (LAS unsigned char*)lds;
    if (args.out == nullptr) cg::this_grid().sync();
    if (hi - lo > 1) {
        for (int u = threadIdx.x; u < (LDS_BYTES - 131072) / 4; u += NTHR) ((LAS unsigned*)(ldsl + 131072))[u] = 0u;
        __syncthreads();
        (void)xcd_barrier_post((unsigned*)args.ws, (volatile LAS unsigned*)(ldsl + MISC_OFF) + 8);
    }

    STAMP(0);
    if (IN(0)) {
        LANEVARS
        LAS float* scr = (LAS float*)(ldsl + wave * 16384);
        constexpr int I_IN = (DM / 64) * (INW / 32), I_O = (DM / 64) * (DM / 32), I_UP = (DM / 64) * (DFF / 32), I_DN = (DFF / 64) * (DM / 32), I_G = I_O, I_P = (PLE / 64) * (DM / 32);
        constexpr int NITEMS = I_IN + I_O + I_UP + I_DN + I_G + I_P;
        for (int it = gw; it < NITEMS; it += NGW) {
            int r = it;
            if (r < I_IN) { p0_transpose_item(A_WIN, DM, INW, (bf16r*)W_(WS_WIN), scr, r, lane, A_GPREMIX); continue; } r -= I_IN;
            if (r < I_O) { p0_transpose_item(A_WO, DM, DM, (bf16r*)W_(WS_WO), scr, r, lane); continue; } r -= I_O;
            if (r < I_UP) { p0_transpose_item(A_WUP, DM, DFF, (bf16r*)W_(WS_WUP), scr, r, lane, A_GPREMLP); continue; } r -= I_UP;
            if (r < I_DN) { p0_transpose_item(A_WDN, DFF, DM, (bf16r*)W_(WS_WDN), scr, r, lane); continue; } r -= I_DN;
            if (r < I_G) { p0_transpose_item(A_WGATE, DM, DM, (bf16r*)W_(WS_WG), scr, r, lane, A_GPREPLE); continue; } r -= I_G;
            p0_transpose_item(A_WPLE, PLE, DM, (bf16r*)W_(WS_WP), scr, r, lane);
        }
        for (int m = gw; m < S; m += NGW) row_norm_bf16(A_X + (size_t)m * DM, (bf16r*)W_(WS_B) + (size_t)m * DM, (float*)W_(WS_RS0) + m, lane);
        for (size_t i = (size_t)bx * NTHR + tid; i < (size_t)S * PLE / 8; i += (size_t)G * NTHR) {
            const f32x4 a = ((const f32x4*)A_P)[2 * i], b = ((const f32x4*)A_P)[2 * i + 1];
            v4u o; o.x = pk2(a.x, a.y); o.y = pk2(a.z, a.w); o.z = pk2(b.x, b.y); o.w = pk2(b.z, b.w); ((v4u*)W_(WS_PBF))[i] = o; }
        __syncthreads();
    }
    SEAM(0); STAMP(1);
    if (IN(1)) {
        pg8::Gemm g{(const bf16r*)W_(WS_B), (const bf16r*)W_(WS_WIN), S, INW, DM}; pg8::StaticOrder So; So.init(S, INW, G, bx);
        pg8::EpiBf16<0, true> E{(bf16r*)W_(WS_A), INW, (const float*)W_(WS_RS0)};
        pg8::gemm_phase<pg8::EpiBf16<0, true>, pg8::StaticOrder, true, true>(ldsl, g, So, E, wave_s);
        const int nu = (S / 256) * (INW / 256), extra = nu % G;
        pg8::Gemm g2{(const bf16r*)W_(WS_PBF), (const bf16r*)W_(WS_WP), S, DM, PLE}; pg8::TailOrder To; To.init(S, DM, G, bx, extra);
        pg8::EpiBf16<0> E2{(bf16r*)W_(WS_B + 64 * MiB), DM};
        pg8::gemm_phase<pg8::EpiBf16<0>, pg8::TailOrder, true, true>(ldsl, g2, To, E2, wave_s);
    }
    SEAM(1); STAMP(2);
    if (IN(2)) {
        LANEVARS
        const int sh = lane >> 4, k = lane & 15, half = k >> 3, kk = k & 7; const bool is_x1 = kk < 4;
        float freq[8], gk[8];
#pragma unroll
        for (int e = 0; e < 8; ++e) { freq[e] = exp2f(-(float)(8 * (kk & 3) + e) * (13.287712379549449f / 32.f)); gk[e] = A_GK[8 * k + e]; }
        bf16r* PROJ = (bf16r*)W_(WS_A);
        const int hd = 8 + (sh & 1);
        int it = gw; v4u raw = {0u, 0u, 0u, 0u};
        if (it < S / 2) raw = *(const v4u*)(PROJ + (size_t)(2 * it + (sh >> 1)) * INW + hd * 128 + 8 * k);
        for (; it < S / 2; it += NGW) {
            const int t = 2 * it + (sh >> 1); const v4u cur = raw;
            { const int it2 = it + NGW; if (it2 < S / 2) raw = *(const v4u*)(PROJ + (size_t)(2 * it2 + (sh >> 1)) * INW + hd * 128 + 8 * k); }
            float xv[8]; float ss = 0.f;
#pragma unroll
            for (int e = 0; e < 4; ++e) { xv[2 * e] = __builtin_bit_cast(float, cur[e] << 16); xv[2 * e + 1] = __builtin_bit_cast(float, cur[e] & 0xffff0000u); }
#pragma unroll
            for (int e = 0; e < 8; ++e) ss += xv[e] * xv[e];
            ss += __shfl_xor(ss, 1); ss += __shfl_xor(ss, 2); ss += __shfl_xor(ss, 4); ss += __shfl_xor(ss, 8);
            const float rs = rsqrtf(ss * (1.f / 128.f) + EPS);
            const float posf = (float)(half ? (t & 63) : (t >> 6));
            float o[8];
#pragma unroll
            for (int e = 0; e < 8; ++e) {
                const float y = xv[e] * rs * gk[e]; const float py = __shfl_xor(y, 4);
                const float ang = posf * freq[e];
                double rev = (double)ang * 0.15915494309189535; rev -= floor(rev);
                const float fr = (float)rev; const float sn = __builtin_amdgcn_sinf(fr), cs = __builtin_amdgcn_cosf(fr);
                o[e] = is_x1 ? y * cs - py * sn : y * cs + py * sn;
            }
            { v4u w; w.x = pk2(o[0], o[1]); w.y = pk2(o[2], o[3]); w.z = pk2(o[4], o[5]); w.w = pk2(o[6], o[7]); *(v4u*)(PROJ + (size_t)t * INW + hd * 128 + 8 * k) = w; }
        }
    }
    SEAM(2); STAMP(3);
    if (IN(3)) {
        char* al = (char*)lds; const bf16r* PROJ = (const bf16r*)W_(WS_A); bf16r* ATT = (bf16r*)W_(WS_A + 144 * MiB); const float* rpb = A_RPB;
#ifndef ATT_NO_A
        for (int u = bx; u < 512; u += G) {
            const int h = u >> 6, qb = u & 63, kvh = h >> 2;
            const att::bf16* Q = (const att::bf16*)PROJ + (size_t)(qb * 256) * INW + h * 128;
            const att::bf16* K = (const att::bf16*)PROJ + 1024 + kvh * 128; const att::bf16* V = (const att::bf16*)PROJ + 1280 + kvh * 128;
            att::attn_dense_pp<false>(Q, K, V, (att::bf16*)ATT + (size_t)(qb * 256) * DM + h * 128, S, al, wave_s, A_GQ, qb * 256, 0);
        }
#endif
        STAMP(12);
#ifndef ATT_NO_B
        for (int u = bx; u < 512; u += G) {
            const int h = u >> 6, qb = u & 63, R = qb * 4, rs = R - 4 < 0 ? 0 : R - 4, re = R + 8 > 256 ? 256 : R + 8;
            LAS float* tbl = (LAS float*)(ldsl + att::PP_TBL);
            int l2_ = __builtin_amdgcn_mbcnt_hi(~0u, __builtin_amdgcn_mbcnt_lo(~0u, 0u)); asm volatile("" : "+v"(l2_));
            for (int i = wave_s * 64 + l2_; i < 15 * 128; i += NTHR) { const int dr = i >> 7, dc = (i & 127) - 48; tbl[i] = (dc >= 0 && dc < 31) ? rpb[h * 465 + dr * 31 + dc] * (1.f / att::SCALE) : 0.f; }
            __syncthreads();
            const att::bf16* Q = (const att::bf16*)PROJ + (size_t)(qb * 256) * INW + 1536 + h * 128;
            const att::bf16* K = (const att::bf16*)PROJ + (size_t)(rs * 64) * INW + 2560 + h * 128; const att::bf16* V = K + 1024;
            att::attn_dense_pp<true>(Q, K, V, (att::bf16*)ATT + (size_t)(qb * 256) * DM + 1024 + h * 128, (re - rs) * 64, al, wave_s, nullptr, qb * 256, rs);
        }
#endif
    }
    SEAM(3); STAMP(4);
    if (IN(4)) {
        pg8::Gemm g{(const bf16r*)W_(WS_A + 144 * MiB), (const bf16r*)W_(WS_WO), S, DM, DM}; pg8::StaticOrder So; So.init(S, DM, G, bx);
        pg8::EpiBf16<0> E{(bf16r*)W_(WS_A), DM};
        pg8::gemm_phase<pg8::EpiBf16<0>, pg8::StaticOrder, true, true>(ldsl, g, So, E, wave_s);
    }
    SEAM(4); STAMP(5);
    if (IN(5)) {
        LANEVARS
        for (int m = gw; m < S; m += NGW) row_res_norm<2, true, true>((const bf16r*)W_(WS_B) + (size_t)m * DM, (const bf16r*)W_(WS_A) + (size_t)m * DM, A_GPOSTMIX, nullptr, (bf16r*)args.out + (size_t)m * DM, nullptr, lane, (float*)W_(WS_RS2) + m);
    }
    SEAM(5); STAMP(6);
    if (IN(6)) {
        pg8::Gemm g{(const bf16r*)args.out, (const bf16r*)W_(WS_WUP), S, DFF, DM};   pg8::StaticOrder So; So.init(S, DFF, G, bx);
        pg8::EpiBf16<2, true> E{(bf16r*)W_(WS_A), DFF, (const float*)W_(WS_RS2)};
        pg8::gemm_phase<pg8::EpiBf16<2, true>, pg8::StaticOrder, true, true>(ldsl, g, So, E, wave_s);
    }
    SEAM(6); STAMP(7);
    if (IN(7)) {
        pg8::Gemm g{(const bf16r*)W_(WS_A), (const bf16r*)W_(WS_WDN), S, DM, DFF}; pg8::StaticOrder So; So.init(S, DM, G, bx);
        pg8::EpiBf16<0> E{(bf16r*)W_(WS_B), DM};
        pg8::gemm_phase<pg8::EpiBf16<0>, pg8::StaticOrder, true, true>(ldsl, g, So, E, wave_s);
    }
    SEAM(7); STAMP(8);
    if (IN(8)) {
        LANEVARS
        for (int m = gw; m < S; m += NGW) row_res_norm<2, true, true>((const bf16r*)args.out + (size_t)m * DM, (const bf16r*)W_(WS_B) + (size_t)m * DM, A_GPOSTMLP, nullptr, (bf16r*)W_(WS_A + 64 * MiB) + (size_t)m * DM, nullptr, lane, (float*)W_(WS_RS3) + m);
    }
    SEAM(8); STAMP(9);
    if (IN(9)) {
        pg8::Gemm g{(const bf16r*)W_(WS_A + 64 * MiB), (const bf16r*)W_(WS_WG), S, DM, DM};   pg8::StaticOrder So; So.init(S, DM, G, bx);
        pg8::EpiBf16<3, true> E{(bf16r*)W_(WS_B + 64 * MiB), DM, (const float*)W_(WS_RS3)};
        pg8::gemm_phase<pg8::EpiBf16<3, true>, pg8::StaticOrder, true, true>(ldsl, g, So, E, wave_s);
    }
    SEAM(9); STAMP(10);
    if (IN(10)) {
        LANEVARS
        for (int m = gw; m < S; m += NGW) row_res_norm<0, true, false>((const bf16r*)W_(WS_A + 64 * MiB) + (size_t)m * DM, (const bf16r*)W_(WS_B + 64 * MiB) + (size_t)m * DM, A_GPOSTPLE, nullptr, args.out + (size_t)m * DM, nullptr, lane);
    }
#ifdef PROBE_K
    __syncthreads(); STAMP(11); __syncthreads();
    if (bx == 0) {
        volatile LAS unsigned* st = (volatile LAS unsigned*)((LAS unsigned char*)lds + MISC_OFF) + 16;
        const float ta = (float)(st[PROBE_K + 1] - st[PROBE_K]) * 0.01f, tr = (float)(st[PROBE_R1] - st[PROBE_R]) * 0.01f;
        const float qa = floorf(ta / (float)PROBE_TA * 32.f + 0.5f) / 32.f, qr = floorf(tr / (float)PROBE_TR * 64.f + 0.5f) / 64.f;
        const int t = wave_s * 64 + __builtin_amdgcn_mbcnt_hi(~0u, __builtin_amdgcn_mbcnt_lo(~0u, 0u));
        if (t == 0) args.out[0] += 0.12f + 0.25f * qa;
        for (int i = t; i < (1 << 19); i += NTHR) args.out[2048 + i] += 0.1f * qr;
    }
#endif
#undef IN
#undef SEAM
}

extern "C" void kernel_launch(void* const* d_in, const int* in_sizes, int n_in, void* d_out, int out_size, void* d_ws, size_t ws_size, hipStream_t stream) {
    static int grid = 0;
    if (grid == 0) {
        if (n_in != 17 || in_sizes[0] != S * DM || out_size != S * DM || ws_size < WS_END) {
            fprintf(stderr, "kernel_launch: shape/workspace mismatch: n_in %d in0 %d out %d ws %zu (need %zu)\n", n_in, n_in > 0 ? in_sizes[0] : -1, out_size, ws_size, (size_t)WS_END); grid = -1; return; }
        int dev = 0, cus = 0, per_cu = 0;
        if (hipGetDevice(&dev) != hipSuccess || hipDeviceGetAttribute(&cus, hipDeviceAttributeMultiprocessorCount, dev) != hipSuccess) { grid = -1; return; }
        if (hipFuncSetAttribute((const void*)mega_fwd, hipFuncAttributeMaxDynamicSharedMemorySize, LDS_BYTES) != hipSuccess) { fprintf(stderr, "kernel_launch: hipFuncSetAttribute failed\n"); grid = -1; return; }
        if (hipOccupancyMaxActiveBlocksPerMultiprocessor(&per_cu, (const void*)mega_fwd, NTHR, LDS_BYTES) != hipSuccess || per_cu < 1) per_cu = 1;
        (void)hipGetLastError();
        grid = cus * (per_cu > 1 ? 1 : per_cu);
    }
    if (grid < 0) return;
    if (hipMemsetAsync((char*)d_ws + WS_CTL, 0, CTL_ZERO_BYTES, stream) != hipSuccess) { fprintf(stderr, "kernel_launch: memset failed\n"); return; }
    Args a{};
    for (int i = 0; i < 17; ++i) a.in[i] = (const float*)d_in[i];
    a.out = (float*)d_out; a.ws = (unsigned char*)d_ws;
    if (MK_N_LAUNCHES == 1) {
        a.ph_lo = 0; a.ph_hi = NPH; void* kargs[] = {&a};
        hipError_t e = hipLaunchCooperativeKernel((const void*)mega_fwd, dim3(grid), dim3(NTHR), kargs, LDS_BYTES, stream);
        if (e != hipSuccess) fprintf(stderr, "kernel_launch: cooperative launch failed: %s (grid %d)\n", hipGetErrorString(e), grid);
    } else {
        for (int k = 0; k < NPH; ++k) { a.ph_lo = k; a.ph_hi = k + 1; hipLaunchKernelGGL(mega_fwd, dim3(grid), dim3(NTHR), LDS_BYTES, stream, a); }
    }
}
```
